# Optimizing an MI355X kernel written in HIP

```python
import jax, jax.numpy as jnp
from jax import lax
import numpy as np

D_MODEL = 1024
BATCH = 8
SEQ = 4096
DEPTH = 2

MIX_WIDTH = D_MODEL
LRU_WIDTH = MIX_WIDTH // 2
LRU_HEADS = 8
LRU_HEAD_DIM = LRU_WIDTH // LRU_HEADS
LRU_CONV_WIDTH = 4
LRU_C = 8.0
SB_HEADS = 8
SB_HEAD_DIM = (MIX_WIDTH - LRU_WIDTH) // SB_HEADS
SB_WIDTH = SB_HEADS * SB_HEAD_DIM
Q_BLOCK = 128
IN_PROJ_WIDTH = 2 * LRU_WIDTH + 3 * SB_WIDTH
CONF_WIDTH = D_MODEL
CONF_CONV_WIDTH = 31
D_FF = 4 * D_MODEL
RMS_EPS = 1e-6
LN_EPS = 1e-5
N_EVEN = (DEPTH + 1) // 2
N_ODD = DEPTH // 2

kernel_name = "hybrid_rglru_stickbreak_conformer_trunk"


def rms_norm(x, g):
    xf = x.astype(jnp.float32)
    y = xf * lax.rsqrt(jnp.mean(xf * xf, axis=-1, keepdims=True) + RMS_EPS)
    return (y * g.astype(jnp.float32)).astype(x.dtype)


def layer_norm(x, g, b):
    xf = x.astype(jnp.float32)
    mu = jnp.mean(xf, axis=-1, keepdims=True)
    xc = xf - mu
    var = jnp.mean(xc * xc, axis=-1, keepdims=True)
    y = xc * lax.rsqrt(var + LN_EPS) * g.astype(jnp.float32) + b.astype(jnp.float32)
    return y.astype(x.dtype)


def causal_depthwise_conv(x, w, b):
    K, C = w.shape
    y = lax.conv_general_dilated(
        x, w[:, None, :].astype(x.dtype), window_strides=(1,), padding=[(K - 1, 0)],
        dimension_numbers=('NWC', 'WIO', 'NWC'), feature_group_count=C)
    return y + b


def rg_lru(x, gate_a_w, gate_a_b, gate_x_w, gate_x_b, lam):
    B, S, _ = x.shape
    xh = x.reshape(B, S, LRU_HEADS, LRU_HEAD_DIM)
    r = jax.nn.sigmoid(jnp.einsum('bshi,hij->bshj', xh, gate_a_w).reshape(B, S, LRU_WIDTH) + gate_a_b).astype(jnp.float32)
    i = jax.nn.sigmoid(jnp.einsum('bshi,hij->bshj', xh, gate_x_w).reshape(B, S, LRU_WIDTH) + gate_x_b).astype(jnp.float32)
    log_a = LRU_C * r * jax.nn.log_sigmoid(lam.astype(jnp.float32))
    a = jnp.exp(log_a)
    inp = jnp.sqrt(jnp.maximum(-jnp.expm1(2.0 * log_a), 0.0)) * (i * x.astype(jnp.float32))

    def combine(left, right):
        a_l, b_l = left
        a_r, b_r = right
        return a_l * a_r, a_r * b_l + b_r

    _, h = lax.associative_scan(combine, (a, inp), axis=1)
    return h.astype(x.dtype)


def stick_breaking_attention(q, k, v):
    B, S, H, Dh = q.shape
    scale = Dh ** -0.5
    out_blocks = []
    for blk in range(S // Q_BLOCK):
        q0 = blk * Q_BLOCK
        q1 = q0 + Q_BLOCK
        z = jnp.einsum('bthd,bshd->bhts', q[:, q0:q1].astype(jnp.float32),
                       k[:, :q1].astype(jnp.float32)) * scale
        t_pos = jnp.arange(q0, q1)[:, None]
        s_pos = jnp.arange(q1)[None, :]
        causal = s_pos < t_pos
        log_keep = jnp.where(causal, jax.nn.log_sigmoid(-z), 0.0)
        log_remain = lax.cumsum(log_keep, axis=3, reverse=True) - log_keep
        w = jnp.where(causal, jnp.exp(jax.nn.log_sigmoid(z) + log_remain), 0.0)
        out_blocks.append(jnp.einsum('bhts,bshd->bthd', w, v[:, :q1].astype(jnp.float32)))
    return jnp.concatenate(out_blocks, axis=1).astype(q.dtype)


def lru_sb_mixer(h, w_in, conv_w, conv_b, ga_w, ga_b, gx_w, gx_b, lam, w_out):
    B, S, _ = h.shape
    proj = h @ w_in
    gate, x_rec, q, k, v = jnp.split(
        proj, [LRU_WIDTH, 2 * LRU_WIDTH, 2 * LRU_WIDTH + SB_WIDTH, 2 * LRU_WIDTH + 2 * SB_WIDTH], axis=-1)
    x_rec = causal_depthwise_conv(x_rec, conv_w, conv_b)
    y_lru = jax.nn.gelu(gate) * rg_lru(x_rec, ga_w, ga_b, gx_w, gx_b, lam)
    y_sb = stick_breaking_attention(
        q.reshape(B, S, SB_HEADS, SB_HEAD_DIM),
        k.reshape(B, S, SB_HEADS, SB_HEAD_DIM),
        v.reshape(B, S, SB_HEADS, SB_HEAD_DIM)).reshape(B, S, SB_WIDTH)
    return jnp.concatenate([y_lru, y_sb], axis=-1) @ w_out


def conformer_conv_module(h, pw1_w, pw1_b, dw_w, dw_b, ln_g, ln_b, pw2_w, pw2_b):
    u = h @ pw1_w + pw1_b
    u = u[..., :CONF_WIDTH] * jax.nn.sigmoid(u[..., CONF_WIDTH:])
    u = causal_depthwise_conv(u, dw_w, dw_b)
    u = jax.nn.silu(layer_norm(u, ln_g, ln_b))
    return u @ pw2_w + pw2_b


def sq_relu_mlp(h, w1, w2):
    a = jax.nn.relu(h @ w1)
    return (a * a) @ w2


def setup_inputs(seed: int = 0) -> dict:
    key = jax.random.key(seed)
    ks = iter(jax.random.split(key, 40))
    f32 = jnp.float32

    def nrm(shape, fan_in):
        return jax.random.normal(next(ks), shape, f32) * (fan_in ** -0.5)

    def gain(shape):
        return 1.0 + 0.02 * jax.random.normal(next(ks), shape, f32)

    def bias(shape):
        return 0.02 * jax.random.normal(next(ks), shape, f32)

    x = jax.random.normal(next(ks), (BATCH, SEQ, D_MODEL), f32)
    ev_norm_g = gain((N_EVEN, D_MODEL))
    ev_w_in = nrm((N_EVEN, D_MODEL, IN_PROJ_WIDTH), D_MODEL)
    ev_conv_w = nrm((N_EVEN, LRU_CONV_WIDTH, LRU_WIDTH), LRU_CONV_WIDTH)
    ev_conv_b = bias((N_EVEN, LRU_WIDTH))
    ev_gate_a_w = nrm((N_EVEN, LRU_HEADS, LRU_HEAD_DIM, LRU_HEAD_DIM), LRU_HEAD_DIM)
    ev_gate_a_b = bias((N_EVEN, LRU_WIDTH))
    ev_gate_x_w = nrm((N_EVEN, LRU_HEADS, LRU_HEAD_DIM, LRU_HEAD_DIM), LRU_HEAD_DIM)
    ev_gate_x_b = bias((N_EVEN, LRU_WIDTH))
    u = jax.random.uniform(next(ks), (N_EVEN, LRU_WIDTH), f32, 0.9, 0.999)
    a0 = u ** (1.0 / LRU_C)
    ev_lam = jnp.log(a0) - jnp.log1p(-a0)
    ev_w_out = nrm((N_EVEN, MIX_WIDTH, D_MODEL), MIX_WIDTH)
    od_norm_g = gain((N_ODD, D_MODEL))
    od_pw1_w = nrm((N_ODD, D_MODEL, 2 * CONF_WIDTH), D_MODEL)
    od_pw1_b = bias((N_ODD, 2 * CONF_WIDTH))
    od_dw_w = nrm((N_ODD, CONF_CONV_WIDTH, CONF_WIDTH), CONF_CONV_WIDTH)
    od_dw_b = bias((N_ODD, CONF_WIDTH))
    od_ln_g = gain((N_ODD, CONF_WIDTH))
    od_ln_b = bias((N_ODD, CONF_WIDTH))
    od_pw2_w = nrm((N_ODD, CONF_WIDTH, D_MODEL), CONF_WIDTH)
    od_pw2_b = bias((N_ODD, D_MODEL))
    mlp_norm_g = gain((DEPTH, D_MODEL))
    mlp_w1 = nrm((DEPTH, D_MODEL, D_FF), D_MODEL)
    mlp_w2 = nrm((DEPTH, D_FF, D_MODEL), D_FF)
    final_g = gain((D_MODEL,))
    return {
        "x": x,
        "ev_norm_g": ev_norm_g, "ev_w_in": ev_w_in, "ev_conv_w": ev_conv_w, "ev_conv_b": ev_conv_b,
        "ev_gate_a_w": ev_gate_a_w, "ev_gate_a_b": ev_gate_a_b, "ev_gate_x_w": ev_gate_x_w,
        "ev_gate_x_b": ev_gate_x_b, "ev_lam": ev_lam, "ev_w_out": ev_w_out,
        "od_norm_g": od_norm_g, "od_pw1_w": od_pw1_w, "od_pw1_b": od_pw1_b, "od_dw_w": od_dw_w,
        "od_dw_b": od_dw_b, "od_ln_g": od_ln_g, "od_ln_b": od_ln_b, "od_pw2_w": od_pw2_w,
        "od_pw2_b": od_pw2_b,
        "mlp_norm_g": mlp_norm_g, "mlp_w1": mlp_w1, "mlp_w2": mlp_w2, "final_g": final_g,
    }


def reference(x, ev_norm_g, ev_w_in, ev_conv_w, ev_conv_b, ev_gate_a_w, ev_gate_a_b,
              ev_gate_x_w, ev_gate_x_b, ev_lam, ev_w_out,
              od_norm_g, od_pw1_w, od_pw1_b, od_dw_w, od_dw_b, od_ln_g, od_ln_b,
              od_pw2_w, od_pw2_b, mlp_norm_g, mlp_w1, mlp_w2, final_g):
    for layer in range(DEPTH):
        j = layer // 2
        if layer % 2 == 0:
            h = rms_norm(x, ev_norm_g[j])
            x = x + lru_sb_mixer(h, ev_w_in[j], ev_conv_w[j], ev_conv_b[j], ev_gate_a_w[j],
                                 ev_gate_a_b[j], ev_gate_x_w[j], ev_gate_x_b[j], ev_lam[j],
                                 ev_w_out[j])
        else:
            h = rms_norm(x, od_norm_g[j])
            x = x + conformer_conv_module(h, od_pw1_w[j], od_pw1_b[j], od_dw_w[j], od_dw_b[j],
                                          od_ln_g[j], od_ln_b[j], od_pw2_w[j], od_pw2_b[j])
        h = rms_norm(x, mlp_norm_g[layer])
        x = x + sq_relu_mlp(h, mlp_w1[layer], mlp_w2[layer])
    return rms_norm(x, final_g)
```

```cpp
#include <hip/hip_runtime.h>
#include <hip/hip_cooperative_groups.h>
#include <cstdio>
#include <cstdint>
namespace cg = cooperative_groups;
namespace pg8 {
#define PG8_LAS __attribute__((address_space(3)))
typedef unsigned short bf16_t;
typedef short bf16x8 __attribute__((ext_vector_type(8)));
typedef float f32x4 __attribute__((ext_vector_type(4)));
typedef unsigned u32x4 __attribute__((ext_vector_type(4)));
constexpr int BM = 256, BK = 64, HALF = 128, HTB = HALF * BK * 2  , STAGE_BYTES = 8 * HTB, NXCD = 8, WGM = 8;

__host__ __device__ __forceinline__ int lds_byte(int r, int c) { const int st = (r >> 4) * 2 + (c >> 5), rr = r & 15, cc = c & 31, ob = rr * 64 + cc * 2; return st * 1024 + (ob ^ (((ob >> 9) & 1) << 5)); }
__host__ __device__ __forceinline__ void stage_rc(int b, int& R, int& C) { const int st = b / 1024, sb = b % 1024, swz = sb ^ (((sb >> 9) & 1) << 5); R = (st >> 1) * 16 + swz / 64; C = (st & 1) * 32 + (swz % 64) / 2; }
__host__ __device__ __forceinline__ int perm32(int rho) { const int n = rho >> 4, i = rho & 15; return 8 * (i >> 2) + 4 * n + (i & 3); }

struct Unit { int pm, pn; };
struct Gemm { const bf16_t* A; const bf16_t* Bt; int M, N, K; };

struct StaticOrder {
    int nM, nN, nwg, G, c;
    __host__ __device__ void init(int M, int N, int G_, int c_) { nM = M / BM; nN = N / BM; nwg = nM * nN; G = G_; c = c_; }
    __host__ __device__ bool next(int i, Unit& u) const {
        const long L = (long)i * G + c; if (L >= nwg) return false;
        int wgid = (int)L; { const int q = nwg / NXCD, r = nwg % NXCD, xcd = wgid % NXCD, off = wgid / NXCD; wgid = (xcd < r ? xcd * (q + 1) : r * (q + 1) + (xcd - r) * q) + off; }
        const int nig = WGM * nN, gid = wgid / nig, fm = gid * WGM, gsz = (nM - fm) < WGM ? (nM - fm) : WGM;
        u.pm = fm + ((wgid % nig) % gsz); u.pn = (wgid % nig) / gsz; return true;
    }
    __device__ __forceinline__ void a_ready(const Unit&) const {}
    __device__ __forceinline__ void done(const Unit&) const {}
};

__device__ __forceinline__ unsigned cvt_pk_bf16(float lo, float hi) { unsigned r; asm volatile("v_cvt_pk_bf16_f32 %0, %1, %2" : "=v"(r) : "v"(lo), "v"(hi)); return r; }
__device__ __forceinline__ float fast_exp(float x) { return __builtin_amdgcn_exp2f(x * 1.4426950408889634f); }
__device__ __forceinline__ float fast_sigmoid(float x) { return __builtin_amdgcn_rcpf(1.f + fast_exp(-x)); }
constexpr float RMS_EPS_ = 1e-6f;
template <int ACT> struct EpiScale {
    static constexpr bool PERM = true, AFTER_DRAIN = false;
    bf16_t* O; int ldc; const float* ss;
    __device__ __forceinline__ void operator()(const f32x4 (&acc)[2][2][4][2], const Unit& u, int wr, int wc, int fr, int fq) const {
        const int row0 = u.pm * BM + wr * 64 + fr, col0 = u.pn * BM + wc * 32 + 8 * fq;
#pragma unroll
        for (int ai = 0; ai < 2; ++ai)
#pragma unroll
            for (int m = 0; m < 4; ++m) { const int row = row0 + ai * HALF + m * 16; const float rs = rsqrtf(ss[row] * (1.0f / 1024.0f) + RMS_EPS_);
                bf16_t* rowp = O + (size_t)row * ldc + col0;
#pragma unroll
                for (int bj = 0; bj < 2; ++bj) { f32x4 v0 = acc[ai][bj][m][0] * rs, v1 = acc[ai][bj][m][1] * rs;
                    if (ACT == 1) {
#pragma unroll
                        for (int e = 0; e < 4; ++e) { const float a0 = fmaxf(v0[e], 0.f), a1 = fmaxf(v1[e], 0.f); v0[e] = a0 * a0; v1[e] = a1 * a1; } }
                    u32x4 w; w.x = cvt_pk_bf16(v0[0], v0[1]); w.y = cvt_pk_bf16(v0[2], v0[3]); w.z = cvt_pk_bf16(v1[0], v1[1]); w.w = cvt_pk_bf16(v1[2], v1[3]);
                    *(u32x4*)(rowp + bj * HALF) = w; } }
    }
};
struct EpiGlu {
    static constexpr bool PERM = true, AFTER_DRAIN = false;
    bf16_t* O; const float* ss; const float* bias;
    __device__ __forceinline__ void operator()(const f32x4 (&acc)[2][2][4][2], const Unit& u, int wr, int wc, int fr, int fq) const {
        const int row0 = u.pm * BM + wr * 64 + fr, ch0 = u.pn * HALF + wc * 32 + 8 * fq;
        f32x4 bv[2], bg[2];
#pragma unroll
        for (int n = 0; n < 2; ++n) { bv[n] = *(const f32x4*)(bias + ch0 + 4 * n); bg[n] = *(const f32x4*)(bias + 1024 + ch0 + 4 * n); }
#pragma unroll
        for (int ai = 0; ai < 2; ++ai)
#pragma unroll
            for (int m = 0; m < 4; ++m) { const int row = row0 + ai * HALF + m * 16; const float rs = rsqrtf(ss[row] * (1.0f / 1024.0f) + RMS_EPS_);
                f32x4 o[2];
#pragma unroll
                for (int n = 0; n < 2; ++n) { const f32x4 v = acc[ai][0][m][n] * rs + bv[n], g = acc[ai][1][m][n] * rs + bg[n];
#pragma unroll
                    for (int e = 0; e < 4; ++e) o[n][e] = v[e] * fast_sigmoid(g[e]); }
                u32x4 w; w.x = cvt_pk_bf16(o[0][0], o[0][1]); w.y = cvt_pk_bf16(o[0][2], o[0][3]); w.z = cvt_pk_bf16(o[1][0], o[1][1]); w.w = cvt_pk_bf16(o[1][2], o[1][3]);
                *(u32x4*)(O + (size_t)row * 1024 + ch0) = w; }
    }
};
struct EpiResid {
    static constexpr bool PERM = true, AFTER_DRAIN = false;
    const float* base; float* outF; bf16_t* outB; const float* bias; float* ssout;
    __device__ __forceinline__ void operator()(const f32x4 (&acc)[2][2][4][2], const Unit& u, int wr, int wc, int fr, int fq) const {
        const int row0 = u.pm * BM + wr * 64 + fr, col0 = u.pn * BM + wc * 32 + 8 * fq;
        f32x4 bv[2][2];
#pragma unroll
        for (int bj = 0; bj < 2; ++bj)
#pragma unroll
            for (int n = 0; n < 2; ++n) bv[bj][n] = bias ? *(const f32x4*)(bias + col0 + bj * HALF + 4 * n) : (f32x4){0.f, 0.f, 0.f, 0.f};
#pragma unroll
        for (int ai = 0; ai < 2; ++ai)
#pragma unroll
            for (int m = 0; m < 4; ++m) { const int row = row0 + ai * HALF + m * 16; const size_t off = (size_t)row * 1024 + col0; float s = 0.f;
#pragma unroll
                for (int bj = 0; bj < 2; ++bj) {
                    const f32x4 b0 = *(const f32x4*)(base + off + bj * HALF), b1 = *(const f32x4*)(base + off + bj * HALF + 4);
                    const f32x4 v0 = acc[ai][bj][m][0] + bv[bj][0] + b0, v1 = acc[ai][bj][m][1] + bv[bj][1] + b1;
                    *(f32x4*)(outF + off + bj * HALF) = v0; *(f32x4*)(outF + off + bj * HALF + 4) = v1;
                    u32x4 w; w.x = cvt_pk_bf16(v0[0], v0[1]); w.y = cvt_pk_bf16(v0[2], v0[3]); w.z = cvt_pk_bf16(v1[0], v1[1]); w.w = cvt_pk_bf16(v1[2], v1[3]);
                    *(u32x4*)(outB + off + bj * HALF) = w;
                    s += (v0[0] * v0[0] + v0[1] * v0[1]) + (v0[2] * v0[2] + v0[3] * v0[3]) + (v1[0] * v1[0] + v1[1] * v1[1]) + (v1[2] * v1[2] + v1[3] * v1[3]); }
                s += __shfl_xor(s, 16); s += __shfl_xor(s, 32);
                if (fq == 0) unsafeAtomicAdd(ssout + row, s);
                asm volatile("" ::: "memory"); }
    }
};
template <class Epi, class Sched, bool ALIGN_EPI = false, bool SP2 = false>
__device__ __forceinline__ void gemm_phase(PG8_LAS unsigned char* lds, const Gemm g, const Sched& S, const Epi& E, const int wid_in) {
    int lane_l = (int)__builtin_amdgcn_mbcnt_hi(~0u, __builtin_amdgcn_mbcnt_lo(~0u, 0u)); asm volatile("" : "+v"(lane_l));
    const int wid = wid_in, lane = lane_l, tid = wid * 64 + lane, wr = wid >> 2, wc = wid & 3, fr = lane & 15, fq = lane >> 4;
    const int K = g.K, nt = K / BK;
    unsigned voffA[2], voffB[2];
#pragma unroll
    for (int i = 0; i < 2; ++i) { int R, C; stage_rc(tid * 16 + i * 8192, R, C); const int Rb = Epi::PERM ? ((R & ~31) + perm32(R & 31)) : R;
        voffA[i] = (unsigned)(R * K + C) * 2u; voffB[i] = (unsigned)(Rb * K + C) * 2u; }
    const size_t kstep = (size_t)(BK * 2);
    const size_t hstep = (size_t)HALF * K * 2;
    const size_t tstep = 2 * hstep;
    const unsigned ldsw = (unsigned)wid * 1024u;
    const int aoff = lds_byte(wr * 64 + fr, fq * 8), boff = lds_byte(wc * 32 + fr, fq * 8);
#define PG8_SA(b, h) (((b) * 2 + (h)) * HTB)
#define PG8_SB(b, h) ((4 + (b) * 2 + (h)) * HTB)
#define PG8_STAGE(bufoff, gbase, voff) do { _Pragma("unroll") for (int _i = 0; _i < 2; ++_i) \
        __builtin_amdgcn_global_load_lds((const unsigned*)((const char*)(gbase) + (voff)[_i]), (PG8_LAS unsigned*)(lds + (bufoff) + ldsw + _i * 8192), 16, 0, 0); } while (0)
#define PG8_LDA(dst, b, h) do { _Pragma("unroll") for (int m = 0; m < 4; ++m) _Pragma("unroll") for (int k = 0; k < 2; ++k) dst[m][k] = *(const PG8_LAS bf16x8*)(lds + PG8_SA(b, h) + aoff + m * 2048 + k * 1024); } while (0)
#define PG8_LDB(dst, b, h) do { _Pragma("unroll") for (int n = 0; n < 2; ++n) _Pragma("unroll") for (int k = 0; k < 2; ++k) dst[n][k] = *(const PG8_LAS bf16x8*)(lds + PG8_SB(b, h) + boff + n * 2048 + k * 1024); } while (0)
#define PG8_MMA(ai, bj, At, Bt) do { __builtin_amdgcn_s_setprio(1); _Pragma("unroll") for (int m = 0; m < 4; ++m) _Pragma("unroll") for (int n = 0; n < 2; ++n) _Pragma("unroll") for (int k = 0; k < 2; ++k) \
        acc[ai][bj][m][n] = __builtin_amdgcn_mfma_f32_16x16x32_bf16(Bt[n][k], At[m][k], acc[ai][bj][m][n], 0, 0, 0); __builtin_amdgcn_s_setprio(0); } while (0)
#define PG8_WAIT_V(n) asm volatile("s_waitcnt vmcnt(" #n ")" ::: "memory")
#define PG8_WAIT_L(n) asm volatile("s_waitcnt lgkmcnt(" #n ")" ::: "memory")
#define PG8_BAR __builtin_amdgcn_s_barrier()
#define PG8_SCHED __builtin_amdgcn_sched_barrier(0)
    Unit cur, nxt; int ui = 0;
    if (!S.next(0, cur)) return;
    f32x4 acc[2][2][4][2];
#pragma unroll
    for (int a = 0; a < 2; ++a)
#pragma unroll
        for (int b = 0; b < 2; ++b)
#pragma unroll
            for (int m = 0; m < 4; ++m)
#pragma unroll
                for (int n = 0; n < 2; ++n) acc[a][b][m][n] = (f32x4){0.f, 0.f, 0.f, 0.f};
    bf16x8 At[4][2], B0[2][2], B1[2][2];
    const char* cA = (const char*)g.A + (size_t)cur.pm * tstep; const char* cB = (const char*)g.Bt + (size_t)cur.pn * tstep;
    S.a_ready(cur);
    if constexpr (SP2) {
        PG8_STAGE(PG8_SB(0, 0), cB, voffB); PG8_STAGE(PG8_SB(0, 1), cB + hstep, voffB); PG8_STAGE(PG8_SA(0, 0), cA, voffA); PG8_STAGE(PG8_SA(0, 1), cA + hstep, voffA);
        if (wr == 1) PG8_BAR;
        PG8_WAIT_V(2); PG8_BAR;
        PG8_STAGE(PG8_SB(1, 0), cB + kstep, voffB); PG8_STAGE(PG8_SA(1, 0), cA + kstep, voffA); PG8_STAGE(PG8_SB(1, 1), cB + hstep + kstep, voffB);
        PG8_WAIT_V(6); PG8_BAR;
    } else {
        PG8_STAGE(PG8_SB(0, 0), cB, voffB); PG8_STAGE(PG8_SA(0, 0), cA, voffA); PG8_STAGE(PG8_SB(0, 1), cB + hstep, voffB); PG8_STAGE(PG8_SA(0, 1), cA + hstep, voffA);
        if (wr == 1) PG8_BAR;
        PG8_WAIT_V(4); PG8_BAR;
        PG8_STAGE(PG8_SB(1, 0), cB + kstep, voffB); PG8_STAGE(PG8_SA(1, 0), cA + kstep, voffA); PG8_STAGE(PG8_SB(1, 1), cB + hstep + kstep, voffB);
        PG8_WAIT_V(6); PG8_BAR;
    }
    for (;;) {
        const bool has_next = S.next(ui + 1, nxt);
        const char* nA = has_next ? (const char*)g.A + (size_t)nxt.pm * tstep : cA; const char* nB = has_next ? (const char*)g.Bt + (size_t)nxt.pn * tstep : cB;
        for (int t = 0; t < nt; t += 2) {
            const bool last = (t == nt - 2);
            const char* a1 = cA + (size_t)(t + 1) * kstep;
            const char* a2 = last ? nA : cA + (size_t)(t + 2) * kstep; const char* b2 = last ? nB : cB + (size_t)(t + 2) * kstep;
            const char* a3 = a2 + kstep; const char* b3 = b2 + kstep;
            if (last && has_next) S.a_ready(nxt);
            if constexpr (SP2) {
            PG8_LDB(B0, 0, 0); PG8_LDB(B1, 0, 1); PG8_SCHED; PG8_LDA(At, 0, 0); PG8_STAGE(PG8_SA(1, 1), a1 + hstep, voffA);
            PG8_WAIT_V(8); PG8_WAIT_L(0); PG8_BAR; PG8_MMA(0, 0, At, B0); PG8_MMA(0, 1, At, B1); PG8_BAR; PG8_SCHED;
            PG8_LDA(At, 0, 1); PG8_STAGE(PG8_SB(0, 0), b2, voffB); PG8_STAGE(PG8_SB(0, 1), b2 + hstep, voffB); PG8_STAGE(PG8_SA(0, 0), a2, voffA);
            PG8_WAIT_V(8); PG8_WAIT_L(0); PG8_BAR; PG8_MMA(1, 0, At, B0); PG8_MMA(1, 1, At, B1); PG8_BAR; PG8_SCHED;
            PG8_LDB(B0, 1, 0); PG8_LDB(B1, 1, 1); PG8_SCHED; PG8_LDA(At, 1, 0); PG8_STAGE(PG8_SA(0, 1), a2 + hstep, voffA);
            PG8_WAIT_V(8); PG8_WAIT_L(0); PG8_BAR; PG8_MMA(0, 0, At, B0); PG8_MMA(0, 1, At, B1); PG8_BAR; PG8_SCHED;
            PG8_LDA(At, 1, 1); PG8_STAGE(PG8_SB(1, 0), b3, voffB); PG8_STAGE(PG8_SB(1, 1), b3 + hstep, voffB); PG8_STAGE(PG8_SA(1, 0), a3, voffA);
            PG8_WAIT_V(8); PG8_WAIT_L(0); PG8_BAR; PG8_MMA(1, 0, At, B0); PG8_MMA(1, 1, At, B1); PG8_BAR; PG8_SCHED;
            } else {
            PG8_LDB(B0, 0, 0); PG8_SCHED; PG8_LDA(At, 0, 0); PG8_STAGE(PG8_SA(1, 1), a1 + hstep, voffA);
            PG8_WAIT_L(8); PG8_BAR; PG8_WAIT_L(0); PG8_MMA(0, 0, At, B0); PG8_BAR; PG8_SCHED;
            PG8_LDB(B1, 0, 1); PG8_STAGE(PG8_SB(0, 0), b2, voffB);
            PG8_BAR; PG8_WAIT_L(0); PG8_MMA(0, 1, At, B1); PG8_BAR;
            PG8_LDA(At, 0, 1); PG8_STAGE(PG8_SA(0, 0), a2, voffA);
            PG8_BAR; PG8_WAIT_L(0); PG8_MMA(1, 0, At, B0); PG8_BAR; PG8_SCHED;
            PG8_STAGE(PG8_SB(0, 1), b2 + hstep, voffB);
            PG8_WAIT_V(6); PG8_BAR; PG8_MMA(1, 1, At, B1); PG8_BAR;
            PG8_LDB(B0, 1, 0); PG8_SCHED; PG8_LDA(At, 1, 0); PG8_STAGE(PG8_SA(0, 1), a2 + hstep, voffA);
            PG8_WAIT_L(8); PG8_BAR; PG8_WAIT_L(0); PG8_MMA(0, 0, At, B0); PG8_BAR; PG8_SCHED;
            PG8_LDB(B1, 1, 1); PG8_STAGE(PG8_SB(1, 0), b3, voffB);
            PG8_BAR; PG8_WAIT_L(0); PG8_MMA(0, 1, At, B1); PG8_BAR;
            PG8_LDA(At, 1, 1); PG8_STAGE(PG8_SA(1, 0), a3, voffA);
            PG8_BAR; PG8_WAIT_L(0); PG8_MMA(1, 0, At, B0); PG8_BAR; PG8_SCHED;
            PG8_STAGE(PG8_SB(1, 1), b3 + hstep, voffB);
            PG8_WAIT_V(6); PG8_BAR; PG8_MMA(1, 1, At, B1); PG8_BAR;
            }
        }
        if constexpr (ALIGN_EPI) { if (wr == 0) PG8_BAR; }
        if constexpr (!Epi::AFTER_DRAIN) { E(acc, cur, wr, wc, fr, fq); S.done(cur); }
        if (!has_next) break;
#pragma unroll
        for (int a = 0; a < 2; ++a)
#pragma unroll
            for (int b = 0; b < 2; ++b)
#pragma unroll
                for (int m = 0; m < 4; ++m)
#pragma unroll
                    for (int n = 0; n < 2; ++n) acc[a][b][m][n] = (f32x4){0.f, 0.f, 0.f, 0.f};
        cur = nxt; cA = nA; cB = nB; ++ui;
        if constexpr (ALIGN_EPI) { if (wr == 1) PG8_BAR; }
    }
    PG8_WAIT_V(0);
    if constexpr (!ALIGN_EPI) { if (wr == 0) PG8_BAR; }
    PG8_BAR;
    if constexpr (Epi::AFTER_DRAIN) { E.fused(acc, cur, wr, wc, fr, fq, lds, wid, lane); S.done(cur); }
#undef PG8_SA
#undef PG8_SB
#undef PG8_STAGE
#undef PG8_LDA
#undef PG8_LDB
#undef PG8_MMA
#undef PG8_WAIT_V
#undef PG8_WAIT_L
#undef PG8_BAR
#undef PG8_SCHED
}
}
using pg8::bf16_t; using pg8::bf16x8; using pg8::f32x4; using pg8::u32x4;
typedef float f32x16 __attribute__((ext_vector_type(16)));
typedef float f32x2 __attribute__((ext_vector_type(2)));
typedef unsigned u32x2 __attribute__((ext_vector_type(2)));
#define LAS __attribute__((address_space(3)))
constexpr int NWAVES = 8;
constexpr int BATCH = 8, SEQ = 4096, D = 1024, M = BATCH * SEQ, FF = 4096, NPROJ = 2560;
constexpr float RMS_EPS = 1e-6f, LN_EPS = 1e-5f;
constexpr float LOG2E = 1.4426950408889634f, LN2 = 0.6931471805599453f;
constexpr size_t MiB = 1u << 20;
constexpr size_t WS_SS = 0;
constexpr size_t WS_SUM = 1 * MiB;
constexpr size_t WS_WIN = 2 * MiB, WS_WOUT = 7 * MiB, WS_W1A = 9 * MiB, WS_W2A = 17 * MiB, WS_PW1 = 25 * MiB, WS_PW2 = 29 * MiB, WS_W1B = 31 * MiB, WS_W2B = 39 * MiB;
constexpr size_t WS_GA = 47 * MiB, WS_GX = 47 * MiB + 65536;
constexpr size_t WS_XB = 64 * MiB;
constexpr size_t WS_PROJ = 128 * MiB;
constexpr size_t WS_YMIX = 288 * MiB;
constexpr size_t WS_H = 128 * MiB;
constexpr size_t WS_GL = 128 * MiB;
constexpr size_t WS_CV = 192 * MiB;
constexpr size_t WS_END = 384 * MiB;
constexpr int LDS_BYTES = 147456;

#define LDS_WAIT() asm volatile("s_waitcnt lgkmcnt(0)" ::: "memory")
__device__ __forceinline__ float fexp2(float x) { return __builtin_amdgcn_exp2f(x); }
__device__ __forceinline__ float flog2(float x) { return __builtin_amdgcn_logf(x); }
__device__ __forceinline__ float fexp(float x) { return fexp2(x * LOG2E); }
__device__ __forceinline__ float fsigmoid(float x) { return __builtin_amdgcn_rcpf(1.f + fexp(-x)); }
__device__ __forceinline__ unsigned pk2(float lo, float hi) { return pg8::cvt_pk_bf16(lo, hi); }
__device__ __forceinline__ float bf_lo(unsigned u) { return __uint_as_float(u << 16); }
__device__ __forceinline__ float bf_hi(unsigned u) { return __uint_as_float(u & 0xffff0000u); }
__device__ __forceinline__ float bf1(bf16_t u) { return __uint_as_float((unsigned)u << 16); }
__device__ __forceinline__ int crow(int r, int hi) { return (r & 3) + 8 * (r >> 2) + 4 * hi; }
__device__ __forceinline__ float wave_sum(float v) {
#pragma unroll
    for (int o = 1; o < 64; o <<= 1) v += __shfl_xor(v, o);
    return v;
}

struct Args { const float* in[24]; float* out; unsigned char* ws; };
__device__ __forceinline__ int LB() { int b = (int)blockIdx.x; asm volatile("" : "+s"(b)); return b; }
__device__ __forceinline__ int LG() { int g = (int)gridDim.x; asm volatile("" : "+s"(g)); return g; }
#define AS4 __attribute__((address_space(4)))
struct ArgView { const AS4 unsigned char* kp;
    __device__ __forceinline__ const float* in(int i) const { return *(const float* const AS4*)(kp + 8 * i); }
    __device__ __forceinline__ float* out() const { return *(float* const AS4*)(kp + 192); }
    __device__ __forceinline__ unsigned char* ws() const { return *(unsigned char* const AS4*)(kp + 200); }
};
__device__ __forceinline__ ArgView argview() { const AS4 unsigned char* kp = (const AS4 unsigned char*)__builtin_amdgcn_kernarg_segment_ptr(); asm volatile("" : "+s"(kp)); return ArgView{kp}; }

__device__ __forceinline__ void p0_transpose_item(const float* W, int K, int N, bf16_t* WT, const float* gk, int glu_perm, LAS float* scr, int item, int lane) {
    const int nblk = N / 32, kb = item / nblk, nb = item % nblk, k0 = 64 * kb, n0 = 32 * nb;
#pragma unroll 8
    for (int i = 0; i < 32; ++i) { const int kk = 2 * i + (lane >> 5); float v = W[(size_t)(k0 + kk) * N + n0 + (lane & 31)]; if (gk) v *= gk[k0 + kk]; scr[kk * 33 + (lane & 31)] = v; }
    LDS_WAIT();
    const int c = lane & 7;
#pragma unroll
    for (int j = 0; j < 4; ++j) { const int n = (lane >> 3) + 8 * j; const LAS float* s = scr + (8 * c) * 33 + n;
        u32x4 o; o.x = pk2(s[0 * 33], s[1 * 33]); o.y = pk2(s[2 * 33], s[3 * 33]); o.z = pk2(s[4 * 33], s[5 * 33]); o.w = pk2(s[6 * 33], s[7 * 33]);
        int nrow = n0 + n;
        if (glu_perm) nrow = (nrow < 1024) ? ((nrow >> 7) * 256 + (nrow & 127)) : ((((nrow - 1024) >> 7) * 256) + 128 + ((nrow - 1024) & 127));
        *(u32x4*)(WT + (size_t)nrow * K + k0 + 8 * c) = o; }
    LDS_WAIT();
}
__device__ __forceinline__ void prologue(const ArgView a, LAS unsigned char* lds, int wave, int lane) {
    lane = (int)__builtin_amdgcn_mbcnt_hi(~0u, __builtin_amdgcn_mbcnt_lo(~0u, 0u)); asm volatile("" : "+v"(lane));
    LAS float* scr = (LAS float*)(lds + wave * 16384);
    unsigned char* ws = a.ws();
    const int gw = blockIdx.x * NWAVES + wave, NGW = gridDim.x * NWAVES;
    constexpr int I_IN = 16 * 80, I_SQ = 16 * 32, I_UP = 16 * 128, I_DN = 64 * 32, I_P1 = 16 * 64, I_G = 16;
    constexpr int NITEMS = I_IN + I_SQ + I_UP + I_DN + I_P1 + I_SQ + I_UP + I_DN + I_G + I_G;
    for (int it = gw; it < NITEMS; it += NGW) {
        int r = it;
        if (r < I_IN) { p0_transpose_item(a.in(2), 1024, NPROJ, (bf16_t*)(ws + WS_WIN), a.in(1), 0, scr, r, lane); continue; } r -= I_IN;
        if (r < I_SQ) { p0_transpose_item(a.in(10), 1024, 1024, (bf16_t*)(ws + WS_WOUT), nullptr, 0, scr, r, lane); continue; } r -= I_SQ;
        if (r < I_UP) { p0_transpose_item(a.in(21), 1024, FF, (bf16_t*)(ws + WS_W1A), a.in(20), 0, scr, r, lane); continue; } r -= I_UP;
        if (r < I_DN) { p0_transpose_item(a.in(22), FF, 1024, (bf16_t*)(ws + WS_W2A), nullptr, 0, scr, r, lane); continue; } r -= I_DN;
        if (r < I_P1) { p0_transpose_item(a.in(12), 1024, 2048, (bf16_t*)(ws + WS_PW1), a.in(11), 1, scr, r, lane); continue; } r -= I_P1;
        if (r < I_SQ) { p0_transpose_item(a.in(18), 1024, 1024, (bf16_t*)(ws + WS_PW2), nullptr, 0, scr, r, lane); continue; } r -= I_SQ;
        if (r < I_UP) { p0_transpose_item(a.in(21) + (size_t)1024 * FF, 1024, FF, (bf16_t*)(ws + WS_W1B), a.in(20) + 1024, 0, scr, r, lane); continue; } r -= I_UP;
        if (r < I_DN) { p0_transpose_item(a.in(22) + (size_t)1024 * FF, FF, 1024, (bf16_t*)(ws + WS_W2B), nullptr, 0, scr, r, lane); continue; } r -= I_DN;
        if (r < I_G) { const int h = r >> 1; p0_transpose_item(a.in(5) + h * 4096, 64, 64, (bf16_t*)(ws + WS_GA) + h * 4096, nullptr, 0, scr, r & 1, lane); continue; } r -= I_G;
        { const int h = r >> 1; p0_transpose_item(a.in(7) + h * 4096, 64, 64, (bf16_t*)(ws + WS_GX) + h * 4096, nullptr, 0, scr, r & 1, lane); }
    }
    const float* x = a.in(0); bf16_t* XB = (bf16_t*)(ws + WS_XB); float* SS = (float*)(ws + WS_SS);
    for (int m = gw; m < M; m += NGW) {
        const f32x4* xr = (const f32x4*)(x + (size_t)m * D) + lane; u32x2* o8 = (u32x2*)(XB + (size_t)m * D) + lane; float s = 0.f;
#pragma unroll
        for (int j = 0; j < 4; ++j) { const f32x4 v = xr[64 * j]; s += (v.x * v.x + v.y * v.y) + (v.z * v.z + v.w * v.w); u32x2 w; w.x = pk2(v.x, v.y); w.y = pk2(v.z, v.w); o8[64 * j] = w; }
        s = wave_sum(s); if (lane == 0) SS[m] = s;
    }
    for (int i = blockIdx.x * 512 + wave * 64 + lane; i < 4 * M; i += gridDim.x * 512) SS[M + i] = 0.f;
}

template <int PASS> __device__ __forceinline__ void lru_item(const ArgView a, LAS unsigned char* wlds, int item, int lane) {
    lane = (int)__builtin_amdgcn_mbcnt_hi(~0u, __builtin_amdgcn_mbcnt_lo(~0u, 0u)); asm volatile("" : "+v"(lane));
    unsigned char* ws = a.ws();
    const bf16_t* PROJ = (const bf16_t*)(ws + WS_PROJ); bf16_t* YMIX = (bf16_t*)(ws + WS_YMIX); float* SUM = (float*)(ws + WS_SUM);
    const int b = item >> 8, c128 = (item >> 3) & 31, h = item & 7;
    const int n = lane & 31, hi = lane >> 5, r8 = lane >> 3, cgp = lane & 7;
    LAS float* XC = (LAS float*)wlds;
    const bf16_t* GA = (const bf16_t*)(ws + WS_GA) + h * 4096; const bf16_t* GX = (const bf16_t*)(ws + WS_GX) + h * 4096;
    bf16x8 wa[2][4], wx[2][4];
#pragma unroll
    for (int nb = 0; nb < 2; ++nb)
#pragma unroll
        for (int ks = 0; ks < 4; ++ks) { wa[nb][ks] = *(const bf16x8*)(GA + (32 * nb + n) * 64 + 16 * ks + 8 * hi); wx[nb][ks] = *(const bf16x8*)(GX + (32 * nb + n) * 64 + 16 * ks + 8 * hi); }
    float ba[2], bx[2], ls8[2], Hc[2], Pt[2];
#pragma unroll
    for (int nb = 0; nb < 2; ++nb) { const int ch = 64 * h + 32 * nb + n; ba[nb] = a.in(6)[ch]; bx[nb] = a.in(8)[ch];
        const float lam = a.in(9)[ch]; ls8[nb] = -8.0f * (fmaxf(-lam, 0.f) + log1pf(expf(-fabsf(lam))));
        Hc[nb] = 0.f; Pt[nb] = 1.f; }
    if (PASS == 2) {
        for (int cc = 0; cc < c128; ++cc) {
#pragma unroll
            for (int nb = 0; nb < 2; ++nb) { const f32x2 ab = *(const f32x2*)(SUM + ((size_t)((b * 32 + cc) * 512 + 64 * h + 32 * nb + n)) * 2); Hc[nb] = ab.x * Hc[nb] + ab.y; } }
    }
    const bf16_t* Xr = PROJ + (size_t)b * SEQ * NPROJ + 512 + 64 * h + 8 * cgp;
#pragma unroll 1
    for (int sub = 0; sub < 4; ++sub) {
        const int t0 = 128 * c128 + 32 * sub;
        float cwv[4][8], cbv[8];
#pragma unroll
        for (int k = 0; k < 4; ++k) { const f32x4 w0 = *(const f32x4*)(a.in(3) + k * 512 + 64 * h + 8 * cgp), w1 = *(const f32x4*)(a.in(3) + k * 512 + 64 * h + 8 * cgp + 4);
#pragma unroll
            for (int e = 0; e < 4; ++e) { cwv[k][e] = w0[e]; cwv[k][4 + e] = w1[e]; } }
        { const f32x4 w0 = *(const f32x4*)(a.in(4) + 64 * h + 8 * cgp), w1 = *(const f32x4*)(a.in(4) + 64 * h + 8 * cgp + 4);
#pragma unroll
          for (int e = 0; e < 4; ++e) { cbv[e] = w0[e]; cbv[4 + e] = w1[e]; } }
        u32x4 xin[7];
#pragma unroll
        for (int i = 0; i < 7; ++i) { const int t = t0 + 4 * r8 - 3 + i; xin[i] = (t >= 0) ? *(const u32x4*)(Xr + (size_t)t * NPROJ) : (u32x4){0u, 0u, 0u, 0u}; }
#pragma unroll
        for (int j = 0; j < 4; ++j) { float o[8];
#pragma unroll
            for (int e = 0; e < 8; ++e) o[e] = cbv[e];
#pragma unroll
            for (int k = 0; k < 4; ++k) { const u32x4 xv = xin[j + k];
#pragma unroll
                for (int e2 = 0; e2 < 4; ++e2) { o[2 * e2] += cwv[k][2 * e2] * bf_lo(xv[e2]); o[2 * e2 + 1] += cwv[k][2 * e2 + 1] * bf_hi(xv[e2]); } }
            *(LAS f32x4*)(XC + (4 * r8 + j) * 68 + 8 * cgp) = (f32x4){o[0], o[1], o[2], o[3]};
            *(LAS f32x4*)(XC + (4 * r8 + j) * 68 + 8 * cgp + 4) = (f32x4){o[4], o[5], o[6], o[7]}; }
        LDS_WAIT();
        bf16x8 af[4];
#pragma unroll
        for (int ks = 0; ks < 4; ++ks) { const f32x4 lo = *(const LAS f32x4*)(XC + n * 68 + 16 * ks + 8 * hi), hv = *(const LAS f32x4*)(XC + n * 68 + 16 * ks + 8 * hi + 4);
            u32x4 w; w.x = pk2(lo[0], lo[1]); w.y = pk2(lo[2], lo[3]); w.z = pk2(hv[0], hv[1]); w.w = pk2(hv[2], hv[3]); af[ks] = __builtin_bit_cast(bf16x8, w); }
#pragma unroll
        for (int nb = 0; nb < 2; ++nb) {
            f32x16 accA = {}, accX = {};
#pragma unroll
            for (int ks = 0; ks < 4; ++ks) { accA = __builtin_amdgcn_mfma_f32_32x32x16_bf16(af[ks], wa[nb][ks], accA, 0, 0, 0); accX = __builtin_amdgcn_mfma_f32_32x32x16_bf16(af[ks], wx[nb][ks], accX, 0, 0, 0); }
            float av[16], iv[16];
#pragma unroll
            for (int i = 0; i < 16; ++i) { const float xv = XC[crow(i, hi) * 68 + 32 * nb + n];
                const float r = fsigmoid(accA[i] + ba[nb]), ig = fsigmoid(accX[i] + bx[nb]);
                const float la = ls8[nb] * r; av[i] = fexp(la); iv[i] = sqrtf(fmaxf(-expm1f(2.0f * la), 0.f)) * (ig * xv); }
            float Ag[4], Bg[4], oA[4], oB[4];
#pragma unroll
            for (int g = 0; g < 4; ++g) { float A = av[4 * g], B = iv[4 * g];
#pragma unroll
                for (int j = 1; j < 4; ++j) { B = av[4 * g + j] * B + iv[4 * g + j]; A *= av[4 * g + j]; }
                Ag[g] = A; Bg[g] = B; }
#pragma unroll
            for (int g = 0; g < 4; ++g) { oA[g] = __shfl_xor(Ag[g], 32); oB[g] = __shfl_xor(Bg[g], 32); }
            float S = Hc[nb], st[4], P = Pt[nb];
#pragma unroll
            for (int g = 0; g < 4; ++g) { const float A0 = hi ? oA[g] : Ag[g], B0 = hi ? oB[g] : Bg[g], A1 = hi ? Ag[g] : oA[g], B1 = hi ? Bg[g] : oB[g];
                const float S1 = A0 * S + B0; st[g] = hi ? S1 : S; S = A1 * S1 + B1; P *= A0 * A1; }
            Hc[nb] = S; Pt[nb] = P;
            if (PASS == 2) {
                const size_t mrow = (size_t)b * SEQ + t0; const int ch = 64 * h + 32 * nb + n;
#pragma unroll
                for (int g = 0; g < 4; ++g) { float hh = st[g];
#pragma unroll
                    for (int j = 0; j < 4; ++j) { const int i = 4 * g + j; hh = av[i] * hh + iv[i];
                        const size_t mr = mrow + crow(i, hi); const float gt = bf1(PROJ[mr * NPROJ + ch]);
                        const float u2 = 1.5957691216057308f * (gt + 0.044715f * gt * gt * gt);
                        const float th = 1.f - 2.f * __builtin_amdgcn_rcpf(1.f + fexp(u2));
                        const float y = 0.5f * gt * (1.f + th) * hh;
                        YMIX[mr * 1024 + ch] = (bf16_t)(pk2(y, y) & 0xffffu); } }
            }
        }
        LDS_WAIT();
    }
    if (PASS == 1 && hi == 0) {
#pragma unroll
        for (int nb = 0; nb < 2; ++nb) *(f32x2*)(SUM + ((size_t)((b * 32 + c128) * 512 + 64 * h + 32 * nb + n)) * 2) = (f32x2){Pt[nb], Hc[nb]};
    }
}

__device__ __forceinline__ void attn_item(const ArgView a, LAS unsigned char* wlds, int item, int lane) {
    lane = (int)__builtin_amdgcn_mbcnt_hi(~0u, __builtin_amdgcn_mbcnt_lo(~0u, 0u)); asm volatile("" : "+v"(lane));
    unsigned char* ws = a.ws();
    const int b = item >> 10, h = (item >> 7) & 7, qi = item & 127;
    const int n = lane & 31, hi = lane >> 5;
    const bf16_t* Pb = (const bf16_t*)(ws + WS_PROJ) + (size_t)b * SEQ * NPROJ;
    bf16_t* YMIX = (bf16_t*)(ws + WS_YMIX);
    bf16x8 qf[4];
#pragma unroll
    for (int ks = 0; ks < 4; ++ks) qf[ks] = *(const bf16x8*)(Pb + (size_t)(32 * qi + n) * NPROJ + 1024 + 64 * h + 16 * ks + 8 * hi);
    f32x16 o0 = {}, o1 = {}; float carry = 0.f;
    for (int kt = qi; kt >= 0; --kt) {
        bf16x8 kf[4];
#pragma unroll
        for (int ks = 0; ks < 4; ++ks) kf[ks] = *(const bf16x8*)(Pb + (size_t)(32 * kt + n) * NPROJ + 1536 + 64 * h + 16 * ks + 8 * hi);
#pragma unroll
        for (int j = 0; j < 4; ++j) { const int idx = lane + 64 * j, key = idx >> 3, piece = idx & 7;
            const u32x4 v = *(const u32x4*)(Pb + (size_t)(32 * kt + key) * NPROJ + 2048 + 64 * h + 8 * piece);
            *(LAS u32x4*)(wlds + key * 144 + piece * 16) = v; }
        f32x16 s = {};
#pragma unroll
        for (int ks = 0; ks < 4; ++ks) s = __builtin_amdgcn_mfma_f32_32x32x16_bf16(kf[ks], qf[ks], s, 0, 0, 0);
        const bool diag = (kt == qi);
        float lk[16], zl[16];
#pragma unroll
        for (int i = 0; i < 16; ++i) { const float z = s[i] * 0.125f; const bool valid = !diag || (crow(i, hi) < n);
            const float sp = fmaxf(z, 0.f) + LN2 * flog2(1.f + fexp2(-fabsf(z) * LOG2E));
            lk[i] = valid ? -sp : 0.f; zl[i] = valid ? (z - sp) : -INFINITY; }
        float T[4], oT[4], after[4];
#pragma unroll
        for (int g = 0; g < 4; ++g) T[g] = (lk[4 * g] + lk[4 * g + 1]) + (lk[4 * g + 2] + lk[4 * g + 3]);
#pragma unroll
        for (int g = 0; g < 4; ++g) oT[g] = __shfl_xor(T[g], 32);
        float Gs = 0.f;
#pragma unroll
        for (int g = 3; g >= 0; --g) { after[g] = Gs + (hi ? 0.f : oT[g]); Gs += T[g] + oT[g]; }
        float w[16];
#pragma unroll
        for (int g = 0; g < 4; ++g) { float suf = carry + after[g];
#pragma unroll
            for (int j = 3; j >= 0; --j) { const int i = 4 * g + j; w[i] = fexp2((zl[i] + suf) * LOG2E); suf += lk[i]; } }
        carry += Gs;
        bf16x8 pf[2];
#pragma unroll
        for (int s2 = 0; s2 < 2; ++s2) { u32x4 pw; pw.x = pk2(w[8 * s2], w[8 * s2 + 1]); pw.y = pk2(w[8 * s2 + 2], w[8 * s2 + 3]); pw.z = pk2(w[8 * s2 + 4], w[8 * s2 + 5]); pw.w = pk2(w[8 * s2 + 6], w[8 * s2 + 7]);
            pf[s2] = __builtin_bit_cast(bf16x8, pw); }
        LDS_WAIT();
#pragma unroll
        for (int d0 = 0; d0 < 2; ++d0)
#pragma unroll
            for (int s2 = 0; s2 < 2; ++s2) { bf16x8 vf;
#pragma unroll
                for (int e = 0; e < 2; ++e)
#pragma unroll
                    for (int j = 0; j < 4; ++j) vf[4 * e + j] = *(const LAS short*)(wlds + (16 * s2 + 4 * hi + j + 8 * e) * 144 + (32 * d0 + n) * 2);
                if (d0 == 0) o0 = __builtin_amdgcn_mfma_f32_32x32x16_bf16(vf, pf[s2], o0, 0, 0, 0); else o1 = __builtin_amdgcn_mfma_f32_32x32x16_bf16(vf, pf[s2], o1, 0, 0, 0); }
        LDS_WAIT();
        if (__all(carry < -104.0f)) break;
    }
    bf16_t* orow = YMIX + ((size_t)b * SEQ + 32 * qi + n) * 1024 + 512 + 64 * h;
#pragma unroll
    for (int g = 0; g < 4; ++g) { u32x2 w0, w1; w0.x = pk2(o0[4 * g], o0[4 * g + 1]); w0.y = pk2(o0[4 * g + 2], o0[4 * g + 3]); w1.x = pk2(o1[4 * g], o1[4 * g + 1]); w1.y = pk2(o1[4 * g + 2], o1[4 * g + 3]);
        *(u32x2*)(orow + 8 * g + 4 * hi) = w0; *(u32x2*)(orow + 32 + 8 * g + 4 * hi) = w1; }
}

__device__ __forceinline__ void conv_phase(const ArgView a, LAS unsigned char* lds, int wave, int lane) {
    lane = (int)__builtin_amdgcn_mbcnt_hi(~0u, __builtin_amdgcn_mbcnt_lo(~0u, 0u)); asm volatile("" : "+v"(lane));
    unsigned char* ws = a.ws();
    const bf16_t* GL = (const bf16_t*)(ws + WS_GL); bf16_t* CV = (bf16_t*)(ws + WS_CV);
    const int c = 128 * wave + 2 * lane;
    f32x2 wk[31];
#pragma unroll
    for (int k = 0; k < 31; ++k) wk[k] = *(const f32x2*)(a.in(14) + k * 1024 + c);
    const f32x2 bb = *(const f32x2*)(a.in(15) + c);
    LAS float* CT = (LAS float*)lds;
    for (int tile = LB(); tile < M / 32; tile += gridDim.x) {
        const int b = tile >> 7, t0 = (tile & 127) * 32; const bf16_t* G = GL + (size_t)b * SEQ * 1024 + c;
        unsigned X[38];
#pragma unroll
        for (int i = 0; i < 30; ++i) { const int t = t0 - 30 + i; X[i] = (t >= 0) ? *(const unsigned*)(G + (size_t)t * 1024) : 0u; }
#pragma unroll 1
        for (int ch = 0; ch < 4; ++ch) {
#pragma unroll
            for (int j = 0; j < 8; ++j) X[30 + j] = *(const unsigned*)(G + (size_t)(t0 + 8 * ch + j) * 1024);
            f32x2 acc[8];
#pragma unroll
            for (int j = 0; j < 8; ++j) acc[j] = bb;
#pragma unroll
            for (int i = 0; i < 38; ++i) { const f32x2 xv = (f32x2){bf_lo(X[i]), bf_hi(X[i])};
#pragma unroll
                for (int j = 0; j < 8; ++j) { const int k = i - j; if (k >= 0 && k <= 30) acc[j] += wk[k] * xv; } }
#pragma unroll
            for (int j = 0; j < 8; ++j) *(LAS f32x2*)(CT + (8 * ch + j) * 1024 + c) = acc[j];
#pragma unroll
            for (int i = 0; i < 30; ++i) X[i] = X[i + 8];
        }
        __syncthreads();
#pragma unroll 1
        for (int tt = 0; tt < 4; ++tt) { const int tok = 4 * wave + tt; const size_t m = (size_t)b * SEQ + t0 + tok;
            f32x4 v[4]; float s = 0.f;
#pragma unroll
            for (int j = 0; j < 4; ++j) { v[j] = *(const LAS f32x4*)(CT + tok * 1024 + 4 * lane + 256 * j); s += (v[j].x + v[j].y) + (v[j].z + v[j].w); }
            const float mean = wave_sum(s) * (1.0f / 1024.0f); float s2 = 0.f;
#pragma unroll
            for (int j = 0; j < 4; ++j) { v[j] = v[j] - mean; s2 += (v[j].x * v[j].x + v[j].y * v[j].y) + (v[j].z * v[j].z + v[j].w * v[j].w); }
            const float rstd = rsqrtf(wave_sum(s2) * (1.0f / 1024.0f) + LN_EPS);
#pragma unroll
            for (int j = 0; j < 4; ++j) { const f32x4 g = *(const f32x4*)(a.in(16) + 4 * lane + 256 * j), bt = *(const f32x4*)(a.in(17) + 4 * lane + 256 * j);
                f32x4 y = v[j] * rstd * g + bt;
#pragma unroll
                for (int e = 0; e < 4; ++e) y[e] = y[e] * fsigmoid(y[e]);
                u32x2 w; w.x = pk2(y[0], y[1]); w.y = pk2(y[2], y[3]); *(u32x2*)(CV + m * 1024 + 4 * lane + 256 * j) = w; }
        }
        __syncthreads();
    }
}

__global__ void __launch_bounds__(NWAVES * 64, 2) trunk_fwd(Args kargs) {
    extern __shared__ __attribute__((aligned(16))) unsigned char lds_raw[];
    cg::grid_group grid = cg::this_grid();
    LAS unsigned char* lds = (LAS unsigned char*)lds_raw;
    const int wave = __builtin_amdgcn_readfirstlane((int)threadIdx.x >> 6); int lane = 0;
    const int G = gridDim.x, gw = blockIdx.x * NWAVES + wave, NGW = G * NWAVES;
    LAS unsigned char* wlds = lds + wave * 16384;

    prologue(argview(), lds, wave, lane);
    grid.sync();
#pragma unroll 1
    for (int L = 0; L < 2; ++L) {
        if (L == 0) {
            { const ArgView a = argview(); unsigned char* ws = a.ws();
              pg8::Gemm g{(const bf16_t*)(ws + WS_XB), (const bf16_t*)(ws + WS_WIN), M, NPROJ, D}; pg8::StaticOrder S; S.init(M, NPROJ, LG(), LB());
              pg8::EpiScale<0> E{(bf16_t*)(ws + WS_PROJ), NPROJ, (const float*)(ws + WS_SS)};
              pg8::gemm_phase<pg8::EpiScale<0>, pg8::StaticOrder, true, true>(lds, g, S, E, wave); }
            grid.sync();
            { const int gwl = LB() * NWAVES + wave, ngw = LG() * NWAVES;
              for (int it = gwl; it < 2048; it += ngw) lru_item<1>(argview(), wlds, it, lane);
              for (int it = gwl; it < 4096; it += ngw) attn_item(argview(), wlds, it, lane); }
            grid.sync();
            { const int gwl = LB() * NWAVES + wave, ngw = LG() * NWAVES;
              for (int it = gwl; it < 2048; it += ngw) lru_item<2>(argview(), wlds, it, lane);
              for (int it = 4096 + gwl; it < 8192; it += ngw) attn_item(argview(), wlds, it, lane); }
            grid.sync();
        } else {
            { const ArgView a = argview(); unsigned char* ws = a.ws();
              pg8::Gemm g{(const bf16_t*)(ws + WS_XB), (const bf16_t*)(ws + WS_PW1), M, 2048, D}; pg8::StaticOrder S; S.init(M, 2048, LG(), LB());
              pg8::EpiGlu E{(bf16_t*)(ws + WS_GL), (const float*)(ws + WS_SS) + 2 * M, a.in(13)};
              pg8::gemm_phase<pg8::EpiGlu, pg8::StaticOrder, true, true>(lds, g, S, E, wave); }
            grid.sync();
            conv_phase(argview(), lds, wave, lane);
            grid.sync();
        }
        { const ArgView a = argview(); unsigned char* ws = a.ws();
          pg8::Gemm g{(const bf16_t*)(ws + (L == 0 ? WS_YMIX : WS_CV)), (const bf16_t*)(ws + (L == 0 ? WS_WOUT : WS_PW2)), M, D, D}; pg8::StaticOrder S; S.init(M, D, LG(), LB());
          pg8::EpiResid E{L == 0 ? a.in(0) : a.out(), a.out(), (bf16_t*)(ws + WS_XB), L == 0 ? nullptr : a.in(19), (float*)(ws + WS_SS) + (2 * L + 1) * M};
          pg8::gemm_phase<pg8::EpiResid, pg8::StaticOrder, true, true>(lds, g, S, E, wave); }
        grid.sync();
        { const ArgView a = argview(); unsigned char* ws = a.ws();
          pg8::Gemm g{(const bf16_t*)(ws + WS_XB), (const bf16_t*)(ws + (L == 0 ? WS_W1A : WS_W1B)), M, FF, D}; pg8::StaticOrder S; S.init(M, FF, LG(), LB());
          pg8::EpiScale<1> E{(bf16_t*)(ws + WS_H), FF, (const float*)(ws + WS_SS) + (2 * L + 1) * M};
          pg8::gemm_phase<pg8::EpiScale<1>, pg8::StaticOrder, true, true>(lds, g, S, E, wave); }
        grid.sync();
        { const ArgView a = argview(); unsigned char* ws = a.ws();
          pg8::Gemm g{(const bf16_t*)(ws + WS_H), (const bf16_t*)(ws + (L == 0 ? WS_W2A : WS_W2B)), M, D, FF}; pg8::StaticOrder S; S.init(M, D, LG(), LB());
          pg8::EpiResid E{a.out(), a.out(), (bf16_t*)(ws + WS_XB), nullptr, (float*)(ws + WS_SS) + (2 * L + 2) * M};
          pg8::gemm_phase<pg8::EpiResid, pg8::StaticOrder, true, true>(lds, g, S, E, wave); }
        grid.sync();
    }
    { const ArgView a = argview(); const float* SS = (const float*)(a.ws() + WS_SS); float* out = a.out(); const float* fg = a.in(23);
      lane = (int)__builtin_amdgcn_mbcnt_hi(~0u, __builtin_amdgcn_mbcnt_lo(~0u, 0u));
      for (int m = gw; m < M; m += NGW) {
        const float rs = rsqrtf(SS[4 * M + m] * (1.0f / 1024.0f) + RMS_EPS);
        f32x4* xr = (f32x4*)(out + (size_t)m * D) + lane; const f32x4* gr = (const f32x4*)fg + lane;
#pragma unroll
        for (int j = 0; j < 4; ++j) xr[64 * j] = xr[64 * j] * rs * gr[64 * j];
      } }
}

extern "C" void kernel_launch(void* const* d_in, const int* in_sizes, int n_in, void* d_out, int out_size, void* d_ws, size_t ws_size, hipStream_t stream) {
    static int grid = 0;
    if (grid == 0) {
        if (n_in != 24 || in_sizes[0] != M * D || out_size != M * D || ws_size < WS_END) { fprintf(stderr, "kernel_launch: unexpected shapes (n_in %d, ws %zu)\n", n_in, ws_size); grid = -1; return; }
        int dev = 0, cus = 0, per_cu = 0;
        hipGetDevice(&dev); hipDeviceGetAttribute(&cus, hipDeviceAttributeMultiprocessorCount, dev);
        hipFuncSetAttribute((const void*)trunk_fwd, hipFuncAttributeMaxDynamicSharedMemorySize, LDS_BYTES);
        hipOccupancyMaxActiveBlocksPerMultiprocessor(&per_cu, (const void*)trunk_fwd, NWAVES * 64, LDS_BYTES);
        if (per_cu < 1) per_cu = 1;
        (void)hipGetLastError();
        grid = cus * per_cu;
    }
    if (grid < 0) return;
    Args a{};
    for (int i = 0; i < 24; ++i) a.in[i] = (const float*)d_in[i];
    a.out = (float*)d_out; a.ws = (unsigned char*)d_ws;
    void* args[] = {&a};
    hipError_t e = hipLaunchCooperativeKernel((const void*)trunk_fwd, dim3(grid), dim3(NWAVES * 64), args, LDS_BYTES, stream);
    if (e != hipSuccess) fprintf(stderr, "cooperative launch failed: %s (grid %d)\n", hipGetErrorString(e), grid);
}
```

```cpp
#include <hip/hip_runtime.h>
#include <hip/hip_cooperative_groups.h>
#include <cstdio>
#include <cstdint>
namespace cg = cooperative_groups;
namespace pg8 {
#define PG8_LAS __attribute__((address_space(3)))
typedef unsigned short bf16_t;
typedef short bf16x8 __attribute__((ext_vector_type(8)));
typedef float f32x4 __attribute__((ext_vector_type(4)));
typedef unsigned u32x4 __attribute__((ext_vector_type(4)));
constexpr int BM = 256, BK = 64, HALF = 128, HTB = HALF * BK * 2  , STAGE_BYTES = 8 * HTB, NXCD = 8, WGM = 8;

__host__ __device__ __forceinline__ int lds_byte(int r, int c) { const int st = (r >> 4) * 2 + (c >> 5), rr = r & 15, cc = c & 31, ob = rr * 64 + cc * 2; return st * 1024 + (ob ^ (((ob >> 9) & 1) << 5)); }
__host__ __device__ __forceinline__ void stage_rc(int b, int& R, int& C) { const int st = b / 1024, sb = b % 1024, swz = sb ^ (((sb >> 9) & 1) << 5); R = (st >> 1) * 16 + swz / 64; C = (st & 1) * 32 + (swz % 64) / 2; }
__host__ __device__ __forceinline__ int perm32(int rho) { const int n = rho >> 4, i = rho & 15; return 8 * (i >> 2) + 4 * n + (i & 3); }

struct Unit { int pm, pn; };
struct Gemm { const bf16_t* A; const bf16_t* Bt; int M, N, K; };

struct StaticOrder {
    int nM, nN, nwg, G, c;
    __host__ __device__ void init(int M, int N, int G_, int c_) { nM = M / BM; nN = N / BM; nwg = nM * nN; G = G_; c = c_; }
    __host__ __device__ bool next(int i, Unit& u) const {
        const long L = (long)i * G + c; if (L >= nwg) return false;
        int wgid = (int)L; { const int q = nwg / NXCD, r = nwg % NXCD, xcd = wgid % NXCD, off = wgid / NXCD; wgid = (xcd < r ? xcd * (q + 1) : r * (q + 1) + (xcd - r) * q) + off; }
        const int nig = WGM * nN, gid = wgid / nig, fm = gid * WGM, gsz = (nM - fm) < WGM ? (nM - fm) : WGM;
        u.pm = fm + ((wgid % nig) % gsz); u.pn = (wgid % nig) / gsz; return true;
    }
    __device__ __forceinline__ void a_ready(const Unit&) const {}
    __device__ __forceinline__ void done(const Unit&) const {}
};

__device__ __forceinline__ unsigned cvt_pk_bf16(float lo, float hi) { unsigned r; asm volatile("v_cvt_pk_bf16_f32 %0, %1, %2" : "=v"(r) : "v"(lo), "v"(hi)); return r; }
__device__ __forceinline__ float fast_exp(float x) { return __builtin_amdgcn_exp2f(x * 1.4426950408889634f); }
__device__ __forceinline__ float fast_sigmoid(float x) { return __builtin_amdgcn_rcpf(1.f + fast_exp(-x)); }
constexpr float RMS_EPS_ = 1e-6f;
template <int ACT> struct EpiScale {
    static constexpr bool PERM = true, AFTER_DRAIN = false;
    bf16_t* O; int ldc; const float* ss;
    __device__ __forceinline__ void operator()(const f32x4 (&acc)[2][2][4][2], const Unit& u, int wr, int wc, int fr, int fq) const {
        const int row0 = u.pm * BM + wr * 64 + fr, col0 = u.pn * BM + wc * 32 + 8 * fq;
#pragma unroll
        for (int ai = 0; ai < 2; ++ai)
#pragma unroll
            for (int m = 0; m < 4; ++m) { const int row = row0 + ai * HALF + m * 16; const float rs = rsqrtf(ss[row] * (1.0f / 1024.0f) + RMS_EPS_);
                bf16_t* rowp = O + (size_t)row * ldc + col0;
#pragma unroll
                for (int bj = 0; bj < 2; ++bj) { f32x4 v0 = acc[ai][bj][m][0] * rs, v1 = acc[ai][bj][m][1] * rs;
                    if (ACT == 1) {
#pragma unroll
                        for (int e = 0; e < 4; ++e) { const float a0 = fmaxf(v0[e], 0.f), a1 = fmaxf(v1[e], 0.f); v0[e] = a0 * a0; v1[e] = a1 * a1; } }
                    u32x4 w; w.x = cvt_pk_bf16(v0[0], v0[1]); w.y = cvt_pk_bf16(v0[2], v0[3]); w.z = cvt_pk_bf16(v1[0], v1[1]); w.w = cvt_pk_bf16(v1[2], v1[3]);
                    *(u32x4*)(rowp + bj * HALF) = w; } }
    }
};
struct EpiGlu {
    static constexpr bool PERM = true, AFTER_DRAIN = false;
    bf16_t* O; const float* ss; const float* bias;
    __device__ __forceinline__ void operator()(const f32x4 (&acc)[2][2][4][2], const Unit& u, int wr, int wc, int fr, int fq) const {
        const int row0 = u.pm * BM + wr * 64 + fr, ch0 = u.pn * HALF + wc * 32 + 8 * fq;
        f32x4 bv[2], bg[2];
#pragma unroll
        for (int n = 0; n < 2; ++n) { bv[n] = *(const f32x4*)(bias + ch0 + 4 * n); bg[n] = *(const f32x4*)(bias + 1024 + ch0 + 4 * n); }
#pragma unroll
        for (int ai = 0; ai < 2; ++ai)
#pragma unroll
            for (int m = 0; m < 4; ++m) { const int row = row0 + ai * HALF + m * 16; const float rs = rsqrtf(ss[row] * (1.0f / 1024.0f) + RMS_EPS_);
                f32x4 o[2];
#pragma unroll
                for (int n = 0; n < 2; ++n) { const f32x4 v = acc[ai][0][m][n] * rs + bv[n], g = acc[ai][1][m][n] * rs + bg[n];
#pragma unroll
                    for (int e = 0; e < 4; ++e) o[n][e] = v[e] * fast_sigmoid(g[e]); }
                u32x4 w; w.x = cvt_pk_bf16(o[0][0], o[0][1]); w.y = cvt_pk_bf16(o[0][2], o[0][3]); w.z = cvt_pk_bf16(o[1][0], o[1][1]); w.w = cvt_pk_bf16(o[1][2], o[1][3]);
                *(u32x4*)(O + (size_t)row * 1024 + ch0) = w; }
    }
};
struct EpiResid {
    static constexpr bool PERM = true, AFTER_DRAIN = false;
    const float* baseF; const bf16_t* baseB; float* outF; bf16_t* outB; const float* bias; float* ssout;
    __device__ __forceinline__ void operator()(const f32x4 (&acc)[2][2][4][2], const Unit& u, int wr, int wc, int fr, int fq) const {
        const int row0 = u.pm * BM + wr * 64 + fr, col0 = u.pn * BM + wc * 32 + 8 * fq;
        f32x4 bv[2][2];
#pragma unroll
        for (int bj = 0; bj < 2; ++bj)
#pragma unroll
            for (int n = 0; n < 2; ++n) bv[bj][n] = bias ? *(const f32x4*)(bias + col0 + bj * HALF + 4 * n) : (f32x4){0.f, 0.f, 0.f, 0.f};
#pragma unroll
        for (int ai = 0; ai < 2; ++ai)
#pragma unroll
            for (int m = 0; m < 4; ++m) { const int row = row0 + ai * HALF + m * 16; const size_t off = (size_t)row * 1024 + col0; float s = 0.f;
#pragma unroll
                for (int bj = 0; bj < 2; ++bj) {
                    f32x4 b0, b1;
                    if (baseF) { b0 = *(const f32x4*)(baseF + off + bj * HALF); b1 = *(const f32x4*)(baseF + off + bj * HALF + 4); }
                    else { const u32x4 r = *(const u32x4*)(baseB + off + bj * HALF);
                        b0 = (f32x4){__uint_as_float(r.x << 16), __uint_as_float(r.x & 0xffff0000u), __uint_as_float(r.y << 16), __uint_as_float(r.y & 0xffff0000u)};
                        b1 = (f32x4){__uint_as_float(r.z << 16), __uint_as_float(r.z & 0xffff0000u), __uint_as_float(r.w << 16), __uint_as_float(r.w & 0xffff0000u)}; }
                    const f32x4 v0 = acc[ai][bj][m][0] + bv[bj][0] + b0, v1 = acc[ai][bj][m][1] + bv[bj][1] + b1;
                    if (outF) { *(f32x4*)(outF + off + bj * HALF) = v0; *(f32x4*)(outF + off + bj * HALF + 4) = v1; }
                    else { u32x4 w; w.x = cvt_pk_bf16(v0[0], v0[1]); w.y = cvt_pk_bf16(v0[2], v0[3]); w.z = cvt_pk_bf16(v1[0], v1[1]); w.w = cvt_pk_bf16(v1[2], v1[3]);
                        *(u32x4*)(outB + off + bj * HALF) = w; }
                    s += (v0[0] * v0[0] + v0[1] * v0[1]) + (v0[2] * v0[2] + v0[3] * v0[3]) + (v1[0] * v1[0] + v1[1] * v1[1]) + (v1[2] * v1[2] + v1[3] * v1[3]); }
                s += __shfl_xor(s, 16); s += __shfl_xor(s, 32);
                if (fq == 0) unsafeAtomicAdd(ssout + row, s);
                asm volatile("" ::: "memory"); }
    }
};
template <class Epi, class Sched, bool ALIGN_EPI = false, bool SP2 = false>
__device__ __forceinline__ void gemm_phase(PG8_LAS unsigned char* lds, const Gemm g, const Sched& S, const Epi& E, const int wid_in) {
    int lane_l = (int)__builtin_amdgcn_mbcnt_hi(~0u, __builtin_amdgcn_mbcnt_lo(~0u, 0u)); asm volatile("" : "+v"(lane_l));
    const int wid = wid_in, lane = lane_l, tid = wid * 64 + lane, wr = wid >> 2, wc = wid & 3, fr = lane & 15, fq = lane >> 4;
    const int K = g.K, nt = K / BK;
    unsigned voffA[2], voffB[2];
#pragma unroll
    for (int i = 0; i < 2; ++i) { int R, C; stage_rc(tid * 16 + i * 8192, R, C); const int Rb = Epi::PERM ? ((R & ~31) + perm32(R & 31)) : R;
        voffA[i] = (unsigned)(R * K + C) * 2u; voffB[i] = (unsigned)(Rb * K + C) * 2u; }
    const size_t kstep = (size_t)(BK * 2);
    const size_t hstep = (size_t)HALF * K * 2;
    const size_t tstep = 2 * hstep;
    const unsigned ldsw = (unsigned)wid * 1024u;
    const int aoff = lds_byte(wr * 64 + fr, fq * 8), boff = lds_byte(wc * 32 + fr, fq * 8);
#define PG8_SA(b, h) (((b) * 2 + (h)) * HTB)
#define PG8_SB(b, h) ((4 + (b) * 2 + (h)) * HTB)
#define PG8_STAGE(bufoff, gbase, voff) do { _Pragma("unroll") for (int _i = 0; _i < 2; ++_i) \
        __builtin_amdgcn_global_load_lds((const unsigned*)((const char*)(gbase) + (voff)[_i]), (PG8_LAS unsigned*)(lds + (bufoff) + ldsw + _i * 8192), 16, 0, 0); } while (0)
#define PG8_LDA(dst, b, h) do { _Pragma("unroll") for (int m = 0; m < 4; ++m) _Pragma("unroll") for (int k = 0; k < 2; ++k) dst[m][k] = *(const PG8_LAS bf16x8*)(lds + PG8_SA(b, h) + aoff + m * 2048 + k * 1024); } while (0)
#define PG8_LDB(dst, b, h) do { _Pragma("unroll") for (int n = 0; n < 2; ++n) _Pragma("unroll") for (int k = 0; k < 2; ++k) dst[n][k] = *(const PG8_LAS bf16x8*)(lds + PG8_SB(b, h) + boff + n * 2048 + k * 1024); } while (0)
#define PG8_MMA(ai, bj, At, Bt) do { __builtin_amdgcn_s_setprio(1); _Pragma("unroll") for (int m = 0; m < 4; ++m) _Pragma("unroll") for (int n = 0; n < 2; ++n) _Pragma("unroll") for (int k = 0; k < 2; ++k) \
        acc[ai][bj][m][n] = __builtin_amdgcn_mfma_f32_16x16x32_bf16(Bt[n][k], At[m][k], acc[ai][bj][m][n], 0, 0, 0); __builtin_amdgcn_s_setprio(0); } while (0)
#define PG8_WAIT_V(n) asm volatile("s_waitcnt vmcnt(" #n ")" ::: "memory")
#define PG8_WAIT_L(n) asm volatile("s_waitcnt lgkmcnt(" #n ")" ::: "memory")
#define PG8_BAR __builtin_amdgcn_s_barrier()
#define PG8_SCHED __builtin_amdgcn_sched_barrier(0)
    Unit cur, nxt; int ui = 0;
    if (!S.next(0, cur)) return;
    f32x4 acc[2][2][4][2];
#pragma unroll
    for (int a = 0; a < 2; ++a)
#pragma unroll
        for (int b = 0; b < 2; ++b)
#pragma unroll
            for (int m = 0; m < 4; ++m)
#pragma unroll
                for (int n = 0; n < 2; ++n) acc[a][b][m][n] = (f32x4){0.f, 0.f, 0.f, 0.f};
    bf16x8 At[4][2], B0[2][2], B1[2][2];
    const char* cA = (const char*)g.A + (size_t)cur.pm * tstep; const char* cB = (const char*)g.Bt + (size_t)cur.pn * tstep;
    S.a_ready(cur);
    if constexpr (SP2) {
        PG8_STAGE(PG8_SB(0, 0), cB, voffB); PG8_STAGE(PG8_SB(0, 1), cB + hstep, voffB); PG8_STAGE(PG8_SA(0, 0), cA, voffA); PG8_STAGE(PG8_SA(0, 1), cA + hstep, voffA);
        if (wr == 1) PG8_BAR;
        PG8_WAIT_V(2); PG8_BAR;
        PG8_STAGE(PG8_SB(1, 0), cB + kstep, voffB); PG8_STAGE(PG8_SA(1, 0), cA + kstep, voffA); PG8_STAGE(PG8_SB(1, 1), cB + hstep + kstep, voffB);
        PG8_WAIT_V(6); PG8_BAR;
    } else {
        PG8_STAGE(PG8_SB(0, 0), cB, voffB); PG8_STAGE(PG8_SA(0, 0), cA, voffA); PG8_STAGE(PG8_SB(0, 1), cB + hstep, voffB); PG8_STAGE(PG8_SA(0, 1), cA + hstep, voffA);
        if (wr == 1) PG8_BAR;
        PG8_WAIT_V(4); PG8_BAR;
        PG8_STAGE(PG8_SB(1, 0), cB + kstep, voffB); PG8_STAGE(PG8_SA(1, 0), cA + kstep, voffA); PG8_STAGE(PG8_SB(1, 1), cB + hstep + kstep, voffB);
        PG8_WAIT_V(6); PG8_BAR;
    }
    for (;;) {
        const bool has_next = S.next(ui + 1, nxt);
        const char* nA = has_next ? (const char*)g.A + (size_t)nxt.pm * tstep : cA; const char* nB = has_next ? (const char*)g.Bt + (size_t)nxt.pn * tstep : cB;
        for (int t = 0; t < nt; t += 2) {
            const bool last = (t == nt - 2);
            const char* a1 = cA + (size_t)(t + 1) * kstep;
            const char* a2 = last ? nA : cA + (size_t)(t + 2) * kstep; const char* b2 = last ? nB : cB + (size_t)(t + 2) * kstep;
            const char* a3 = a2 + kstep; const char* b3 = b2 + kstep;
            if (last && has_next) S.a_ready(nxt);
            if constexpr (SP2) {
            PG8_LDB(B0, 0, 0); PG8_LDB(B1, 0, 1); PG8_SCHED; PG8_LDA(At, 0, 0); PG8_STAGE(PG8_SA(1, 1), a1 + hstep, voffA);
            PG8_WAIT_V(8); PG8_WAIT_L(0); PG8_BAR; PG8_MMA(0, 0, At, B0); PG8_MMA(0, 1, At, B1); PG8_BAR; PG8_SCHED;
            PG8_LDA(At, 0, 1); PG8_STAGE(PG8_SB(0, 0), b2, voffB); PG8_STAGE(PG8_SB(0, 1), b2 + hstep, voffB); PG8_STAGE(PG8_SA(0, 0), a2, voffA);
            PG8_WAIT_V(8); PG8_WAIT_L(0); PG8_BAR; PG8_MMA(1, 0, At, B0); PG8_MMA(1, 1, At, B1); PG8_BAR; PG8_SCHED;
            PG8_LDB(B0, 1, 0); PG8_LDB(B1, 1, 1); PG8_SCHED; PG8_LDA(At, 1, 0); PG8_STAGE(PG8_SA(0, 1), a2 + hstep, voffA);
            PG8_WAIT_V(8); PG8_WAIT_L(0); PG8_BAR; PG8_MMA(0, 0, At, B0); PG8_MMA(0, 1, At, B1); PG8_BAR; PG8_SCHED;
            PG8_LDA(At, 1, 1); PG8_STAGE(PG8_SB(1, 0), b3, voffB); PG8_STAGE(PG8_SB(1, 1), b3 + hstep, voffB); PG8_STAGE(PG8_SA(1, 0), a3, voffA);
            PG8_WAIT_V(8); PG8_WAIT_L(0); PG8_BAR; PG8_MMA(1, 0, At, B0); PG8_MMA(1, 1, At, B1); PG8_BAR; PG8_SCHED;
            } else {
            PG8_LDB(B0, 0, 0); PG8_SCHED; PG8_LDA(At, 0, 0); PG8_STAGE(PG8_SA(1, 1), a1 + hstep, voffA);
            PG8_WAIT_L(8); PG8_BAR; PG8_WAIT_L(0); PG8_MMA(0, 0, At, B0); PG8_BAR; PG8_SCHED;
            PG8_LDB(B1, 0, 1); PG8_STAGE(PG8_SB(0, 0), b2, voffB);
            PG8_BAR; PG8_WAIT_L(0); PG8_MMA(0, 1, At, B1); PG8_BAR;
            PG8_LDA(At, 0, 1); PG8_STAGE(PG8_SA(0, 0), a2, voffA);
            PG8_BAR; PG8_WAIT_L(0); PG8_MMA(1, 0, At, B0); PG8_BAR; PG8_SCHED;
            PG8_STAGE(PG8_SB(0, 1), b2 + hstep, voffB);
            PG8_WAIT_V(6); PG8_BAR; PG8_MMA(1, 1, At, B1); PG8_BAR;
            PG8_LDB(B0, 1, 0); PG8_SCHED; PG8_LDA(At, 1, 0); PG8_STAGE(PG8_SA(0, 1), a2 + hstep, voffA);
            PG8_WAIT_L(8); PG8_BAR; PG8_WAIT_L(0); PG8_MMA(0, 0, At, B0); PG8_BAR; PG8_SCHED;
            PG8_LDB(B1, 1, 1); PG8_STAGE(PG8_SB(1, 0), b3, voffB);
            PG8_BAR; PG8_WAIT_L(0); PG8_MMA(0, 1, At, B1); PG8_BAR;
            PG8_LDA(At, 1, 1); PG8_STAGE(PG8_SA(1, 0), a3, voffA);
            PG8_BAR; PG8_WAIT_L(0); PG8_MMA(1, 0, At, B0); PG8_BAR; PG8_SCHED;
            PG8_STAGE(PG8_SB(1, 1), b3 + hstep, voffB);
            PG8_WAIT_V(6); PG8_BAR; PG8_MMA(1, 1, At, B1); PG8_BAR;
            }
        }
        if constexpr (ALIGN_EPI) { if (wr == 0) PG8_BAR; }
        if constexpr (!Epi::AFTER_DRAIN) { E(acc, cur, wr, wc, fr, fq); S.done(cur); }
        if (!has_next) break;
#pragma unroll
        for (int a = 0; a < 2; ++a)
#pragma unroll
            for (int b = 0; b < 2; ++b)
#pragma unroll
                for (int m = 0; m < 4; ++m)
#pragma unroll
                    for (int n = 0; n < 2; ++n) acc[a][b][m][n] = (f32x4){0.f, 0.f, 0.f, 0.f};
        cur = nxt; cA = nA; cB = nB; ++ui;
        if constexpr (ALIGN_EPI) { if (wr == 1) PG8_BAR; }
    }
    PG8_WAIT_V(0);
    if constexpr (!ALIGN_EPI) { if (wr == 0) PG8_BAR; }
    PG8_BAR;
    if constexpr (Epi::AFTER_DRAIN) { E.fused(acc, cur, wr, wc, fr, fq, lds, wid, lane); S.done(cur); }
#undef PG8_SA
#undef PG8_SB
#undef PG8_STAGE
#undef PG8_LDA
#undef PG8_LDB
#undef PG8_MMA
#undef PG8_WAIT_V
#undef PG8_WAIT_L
#undef PG8_BAR
#undef PG8_SCHED
}
}
using pg8::bf16_t; using pg8::bf16x8; using pg8::f32x4; using pg8::u32x4;
typedef float f32x16 __attribute__((ext_vector_type(16)));
typedef float f32x2 __attribute__((ext_vector_type(2)));
typedef unsigned u32x2 __attribute__((ext_vector_type(2)));
#define LAS __attribute__((address_space(3)))
constexpr int NWAVES = 8;
constexpr int BATCH = 8, SEQ = 4096, D = 1024, M = BATCH * SEQ, FF = 4096, NPROJ = 2560;
constexpr float RMS_EPS = 1e-6f, LN_EPS = 1e-5f;
constexpr float LOG2E = 1.4426950408889634f, LN2 = 0.6931471805599453f;
constexpr size_t MiB = 1u << 20;
constexpr size_t WS_SS = 0;
constexpr size_t WS_BAR = 768 * 1024;
constexpr size_t WS_SUM = 1 * MiB;
constexpr size_t WS_WIN = 2 * MiB, WS_WOUT = 7 * MiB, WS_W1A = 9 * MiB, WS_W2A = 17 * MiB, WS_PW1 = 25 * MiB, WS_PW2 = 29 * MiB, WS_W1B = 31 * MiB, WS_W2B = 39 * MiB;
constexpr size_t WS_GA = 47 * MiB, WS_GX = 47 * MiB + 65536;
constexpr size_t WS_XB = 64 * MiB;
constexpr size_t WS_PROJ = 128 * MiB;
constexpr size_t WS_YMIX = 288 * MiB;
constexpr size_t WS_H = 128 * MiB;
constexpr size_t WS_GL = 128 * MiB;
constexpr size_t WS_CV = 192 * MiB;
constexpr size_t WS_END = 384 * MiB;
constexpr int MISC_OFF = 131072 + 320;
constexpr int LDS_BYTES = 147456;

#define LDS_WAIT() asm volatile("s_waitcnt lgkmcnt(0)" ::: "memory")
__device__ __forceinline__ float fexp2(float x) { return __builtin_amdgcn_exp2f(x); }
__device__ __forceinline__ float flog2(float x) { return __builtin_amdgcn_logf(x); }
__device__ __forceinline__ float fexp(float x) { return fexp2(x * LOG2E); }
__device__ __forceinline__ float fsigmoid(float x) { return __builtin_amdgcn_rcpf(1.f + fexp(-x)); }
__device__ __forceinline__ unsigned pk2(float lo, float hi) { return pg8::cvt_pk_bf16(lo, hi); }
__device__ __forceinline__ float bf_lo(unsigned u) { return __uint_as_float(u << 16); }
__device__ __forceinline__ float bf_hi(unsigned u) { return __uint_as_float(u & 0xffff0000u); }
__device__ __forceinline__ float bf1(bf16_t u) { return __uint_as_float((unsigned)u << 16); }
__device__ __forceinline__ int crow(int r, int hi) { return (r & 3) + 8 * (r >> 2) + 4 * hi; }
__device__ __forceinline__ float wave_sum(float v) {
#pragma unroll
    for (int o = 1; o < 64; o <<= 1) v += __shfl_xor(v, o);
    return v;
}

struct Args { const float* in[24]; float* out; unsigned char* ws; };
__device__ __forceinline__ int LB() { int b = (int)blockIdx.x; asm volatile("" : "+s"(b)); return b; }
__device__ __forceinline__ int LG() { int g = (int)gridDim.x; asm volatile("" : "+s"(g)); return g; }
#define AS4 __attribute__((address_space(4)))
struct ArgView { const AS4 unsigned char* kp;
    __device__ __forceinline__ const float* in(int i) const { return *(const float* const AS4*)(kp + 8 * i); }
    __device__ __forceinline__ float* out() const { return *(float* const AS4*)(kp + 192); }
    __device__ __forceinline__ unsigned char* ws() const { return *(unsigned char* const AS4*)(kp + 200); }
};
__device__ __forceinline__ ArgView argview() { const AS4 unsigned char* kp = (const AS4 unsigned char*)__builtin_amdgcn_kernarg_segment_ptr(); asm volatile("" : "+s"(kp)); return ArgView{kp}; }

__device__ __forceinline__ void p0_transpose_item(const float* W, int K, int N, bf16_t* WT, const float* gk, int glu_perm, LAS float* scr, int item, int lane) {
    const int nblk = N / 32, kb = item / nblk, nb = item % nblk, k0 = 64 * kb, n0 = 32 * nb;
#pragma unroll 8
    for (int i = 0; i < 32; ++i) { const int kk = 2 * i + (lane >> 5); float v = W[(size_t)(k0 + kk) * N + n0 + (lane & 31)]; if (gk) v *= gk[k0 + kk]; scr[kk * 33 + (lane & 31)] = v; }
    LDS_WAIT();
    const int c = lane & 7;
#pragma unroll
    for (int j = 0; j < 4; ++j) { const int n = (lane >> 3) + 8 * j; const LAS float* s = scr + (8 * c) * 33 + n;
        u32x4 o; o.x = pk2(s[0 * 33], s[1 * 33]); o.y = pk2(s[2 * 33], s[3 * 33]); o.z = pk2(s[4 * 33], s[5 * 33]); o.w = pk2(s[6 * 33], s[7 * 33]);
        int nrow = n0 + n;
        if (glu_perm) nrow = (nrow < 1024) ? ((nrow >> 7) * 256 + (nrow & 127)) : ((((nrow - 1024) >> 7) * 256) + 128 + ((nrow - 1024) & 127));
        *(u32x4*)(WT + (size_t)nrow * K + k0 + 8 * c) = o; }
    LDS_WAIT();
}
__device__ __forceinline__ void prologue(const ArgView a, LAS unsigned char* lds, int wave, int lane) {
    lane = (int)__builtin_amdgcn_mbcnt_hi(~0u, __builtin_amdgcn_mbcnt_lo(~0u, 0u)); asm volatile("" : "+v"(lane));
    LAS float* scr = (LAS float*)(lds + wave * 16384);
    unsigned char* ws = a.ws();
    const int gw = blockIdx.x * NWAVES + wave, NGW = gridDim.x * NWAVES;
    constexpr int I_IN = 16 * 80, I_SQ = 16 * 32, I_UP = 16 * 128, I_DN = 64 * 32, I_P1 = 16 * 64, I_G = 16;
    constexpr int NITEMS = I_IN + I_SQ + I_UP + I_DN + I_P1 + I_SQ + I_UP + I_DN + I_G + I_G;
    for (int it = gw; it < NITEMS; it += NGW) {
        int r = it;
        if (r < I_IN) { p0_transpose_item(a.in(2), 1024, NPROJ, (bf16_t*)(ws + WS_WIN), a.in(1), 0, scr, r, lane); continue; } r -= I_IN;
        if (r < I_SQ) { p0_transpose_item(a.in(10), 1024, 1024, (bf16_t*)(ws + WS_WOUT), nullptr, 0, scr, r, lane); continue; } r -= I_SQ;
        if (r < I_UP) { p0_transpose_item(a.in(21), 1024, FF, (bf16_t*)(ws + WS_W1A), a.in(20), 0, scr, r, lane); continue; } r -= I_UP;
        if (r < I_DN) { p0_transpose_item(a.in(22), FF, 1024, (bf16_t*)(ws + WS_W2A), nullptr, 0, scr, r, lane); continue; } r -= I_DN;
        if (r < I_P1) { p0_transpose_item(a.in(12), 1024, 2048, (bf16_t*)(ws + WS_PW1), a.in(11), 1, scr, r, lane); continue; } r -= I_P1;
        if (r < I_SQ) { p0_transpose_item(a.in(18), 1024, 1024, (bf16_t*)(ws + WS_PW2), nullptr, 0, scr, r, lane); continue; } r -= I_SQ;
        if (r < I_UP) { p0_transpose_item(a.in(21) + (size_t)1024 * FF, 1024, FF, (bf16_t*)(ws + WS_W1B), a.in(20) + 1024, 0, scr, r, lane); continue; } r -= I_UP;
        if (r < I_DN) { p0_transpose_item(a.in(22) + (size_t)1024 * FF, FF, 1024, (bf16_t*)(ws + WS_W2B), nullptr, 0, scr, r, lane); continue; } r -= I_DN;
        if (r < I_G) { const int h = r >> 1; p0_transpose_item(a.in(5) + h * 4096, 64, 64, (bf16_t*)(ws + WS_GA) + h * 4096, nullptr, 0, scr, r & 1, lane); continue; } r -= I_G;
        { const int h = r >> 1; p0_transpose_item(a.in(7) + h * 4096, 64, 64, (bf16_t*)(ws + WS_GX) + h * 4096, nullptr, 0, scr, r & 1, lane); }
    }
    const float* x = a.in(0); bf16_t* XB = (bf16_t*)(ws + WS_XB); float* SS = (float*)(ws + WS_SS);
    for (int m = gw; m < M; m += NGW) {
        const f32x4* xr = (const f32x4*)(x + (size_t)m * D) + lane; u32x2* o8 = (u32x2*)(XB + (size_t)m * D) + lane; float s = 0.f;
#pragma unroll
        for (int j = 0; j < 4; ++j) { const f32x4 v = xr[64 * j]; s += (v.x * v.x + v.y * v.y) + (v.z * v.z + v.w * v.w); u32x2 w; w.x = pk2(v.x, v.y); w.y = pk2(v.z, v.w); o8[64 * j] = w; }
        s = wave_sum(s); if (lane == 0) SS[m] = s;
    }
    for (int i = blockIdx.x * 512 + wave * 64 + lane; i < 4 * M; i += gridDim.x * 512) SS[M + i] = 0.f;
}

template <int PASS> __device__ __forceinline__ void lru_item(const ArgView a, LAS unsigned char* wlds, int item, int lane) {
    lane = (int)__builtin_amdgcn_mbcnt_hi(~0u, __builtin_amdgcn_mbcnt_lo(~0u, 0u)); asm volatile("" : "+v"(lane));
    unsigned char* ws = a.ws();
    const bf16_t* PROJ = (const bf16_t*)(ws + WS_PROJ); bf16_t* YMIX = (bf16_t*)(ws + WS_YMIX); float* SUM = (float*)(ws + WS_SUM);
    const int b = item >> 8, c128 = (item >> 3) & 31, h = item & 7;
    const int n = lane & 31, hi = lane >> 5, r8 = lane >> 3, cgp = lane & 7;
    LAS float* XC = (LAS float*)wlds;
    const bf16_t* GA = (const bf16_t*)(ws + WS_GA) + h * 4096; const bf16_t* GX = (const bf16_t*)(ws + WS_GX) + h * 4096;
    bf16x8 wa[2][4], wx[2][4];
#pragma unroll
    for (int nb = 0; nb < 2; ++nb)
#pragma unroll
        for (int ks = 0; ks < 4; ++ks) { wa[nb][ks] = *(const bf16x8*)(GA + (32 * nb + n) * 64 + 16 * ks + 8 * hi); wx[nb][ks] = *(const bf16x8*)(GX + (32 * nb + n) * 64 + 16 * ks + 8 * hi); }
    float ba[2], bx[2], ls8[2], Hc[2], Pt[2];
#pragma unroll
    for (int nb = 0; nb < 2; ++nb) { const int ch = 64 * h + 32 * nb + n; ba[nb] = a.in(6)[ch]; bx[nb] = a.in(8)[ch];
        const float lam = a.in(9)[ch]; ls8[nb] = -8.0f * (fmaxf(-lam, 0.f) + log1pf(expf(-fabsf(lam))));
        Hc[nb] = 0.f; Pt[nb] = 1.f; }
    if (PASS == 2) {
        for (int cc = 0; cc < c128; ++cc) {
#pragma unroll
            for (int nb = 0; nb < 2; ++nb) { const f32x2 ab = *(const f32x2*)(SUM + ((size_t)((b * 32 + cc) * 512 + 64 * h + 32 * nb + n)) * 2); Hc[nb] = ab.x * Hc[nb] + ab.y; } }
    }
    const bf16_t* Xr = PROJ + (size_t)b * SEQ * NPROJ + 512 + 64 * h + 8 * cgp;
#pragma unroll 1
    for (int sub = 0; sub < 4; ++sub) {
        const int t0 = 128 * c128 + 32 * sub;
        float cwv[4][8], cbv[8];
#pragma unroll
        for (int k = 0; k < 4; ++k) { const f32x4 w0 = *(const f32x4*)(a.in(3) + k * 512 + 64 * h + 8 * cgp), w1 = *(const f32x4*)(a.in(3) + k * 512 + 64 * h + 8 * cgp + 4);
#pragma unroll
            for (int e = 0; e < 4; ++e) { cwv[k][e] = w0[e]; cwv[k][4 + e] = w1[e]; } }
        { const f32x4 w0 = *(const f32x4*)(a.in(4) + 64 * h + 8 * cgp), w1 = *(const f32x4*)(a.in(4) + 64 * h + 8 * cgp + 4);
#pragma unroll
          for (int e = 0; e < 4; ++e) { cbv[e] = w0[e]; cbv[4 + e] = w1[e]; } }
        u32x4 xin[7];
#pragma unroll
        for (int i = 0; i < 7; ++i) { const int t = t0 + 4 * r8 - 3 + i; xin[i] = (t >= 0) ? *(const u32x4*)(Xr + (size_t)t * NPROJ) : (u32x4){0u, 0u, 0u, 0u}; }
#pragma unroll
        for (int j = 0; j < 4; ++j) { float o[8];
#pragma unroll
            for (int e = 0; e < 8; ++e) o[e] = cbv[e];
#pragma unroll
            for (int k = 0; k < 4; ++k) { const u32x4 xv = xin[j + k];
#pragma unroll
                for (int e2 = 0; e2 < 4; ++e2) { o[2 * e2] += cwv[k][2 * e2] * bf_lo(xv[e2]); o[2 * e2 + 1] += cwv[k][2 * e2 + 1] * bf_hi(xv[e2]); } }
            *(LAS f32x4*)(XC + (4 * r8 + j) * 68 + 8 * cgp) = (f32x4){o[0], o[1], o[2], o[3]};
            *(LAS f32x4*)(XC + (4 * r8 + j) * 68 + 8 * cgp + 4) = (f32x4){o[4], o[5], o[6], o[7]}; }
        LDS_WAIT();
        bf16x8 af[4];
#pragma unroll
        for (int ks = 0; ks < 4; ++ks) { const f32x4 lo = *(const LAS f32x4*)(XC + n * 68 + 16 * ks + 8 * hi), hv = *(const LAS f32x4*)(XC + n * 68 + 16 * ks + 8 * hi + 4);
            u32x4 w; w.x = pk2(lo[0], lo[1]); w.y = pk2(lo[2], lo[3]); w.z = pk2(hv[0], hv[1]); w.w = pk2(hv[2], hv[3]); af[ks] = __builtin_bit_cast(bf16x8, w); }
#pragma unroll
        for (int nb = 0; nb < 2; ++nb) {
            f32x16 accA = {}, accX = {};
#pragma unroll
            for (int ks = 0; ks < 4; ++ks) { accA = __builtin_amdgcn_mfma_f32_32x32x16_bf16(af[ks], wa[nb][ks], accA, 0, 0, 0); accX = __builtin_amdgcn_mfma_f32_32x32x16_bf16(af[ks], wx[nb][ks], accX, 0, 0, 0); }
            float av[16], iv[16];
#pragma unroll
            for (int i = 0; i < 16; ++i) { const float xv = XC[crow(i, hi) * 68 + 32 * nb + n];
                const float r = fsigmoid(accA[i] + ba[nb]), ig = fsigmoid(accX[i] + bx[nb]);
                const float la = ls8[nb] * r; av[i] = fexp(la); iv[i] = sqrtf(fmaxf(-expm1f(2.0f * la), 0.f)) * (ig * xv); }
            float Ag[4], Bg[4], oA[4], oB[4];
#pragma unroll
            for (int g = 0; g < 4; ++g) { float A = av[4 * g], B = iv[4 * g];
#pragma unroll
                for (int j = 1; j < 4; ++j) { B = av[4 * g + j] * B + iv[4 * g + j]; A *= av[4 * g + j]; }
                Ag[g] = A; Bg[g] = B; }
#pragma unroll
            for (int g = 0; g < 4; ++g) { oA[g] = __shfl_xor(Ag[g], 32); oB[g] = __shfl_xor(Bg[g], 32); }
            float S = Hc[nb], st[4], P = Pt[nb];
#pragma unroll
            for (int g = 0; g < 4; ++g) { const float A0 = hi ? oA[g] : Ag[g], B0 = hi ? oB[g] : Bg[g], A1 = hi ? Ag[g] : oA[g], B1 = hi ? Bg[g] : oB[g];
                const float S1 = A0 * S + B0; st[g] = hi ? S1 : S; S = A1 * S1 + B1; P *= A0 * A1; }
            Hc[nb] = S; Pt[nb] = P;
            if (PASS == 2) {
                const size_t mrow = (size_t)b * SEQ + t0; const int ch = 64 * h + 32 * nb + n;
#pragma unroll
                for (int g = 0; g < 4; ++g) { float hh = st[g];
#pragma unroll
                    for (int j = 0; j < 4; ++j) { const int i = 4 * g + j; hh = av[i] * hh + iv[i];
                        const size_t mr = mrow + crow(i, hi); const float gt = bf1(PROJ[mr * NPROJ + ch]);
                        const float u2 = 1.5957691216057308f * (gt + 0.044715f * gt * gt * gt);
                        const float th = 1.f - 2.f * __builtin_amdgcn_rcpf(1.f + fexp(u2));
                        const float y = 0.5f * gt * (1.f + th) * hh;
                        YMIX[mr * 1024 + ch] = (bf16_t)(pk2(y, y) & 0xffffu); } }
            }
        }
        LDS_WAIT();
    }
    if (PASS == 1 && hi == 0) {
#pragma unroll
        for (int nb = 0; nb < 2; ++nb) *(f32x2*)(SUM + ((size_t)((b * 32 + c128) * 512 + 64 * h + 32 * nb + n)) * 2) = (f32x2){Pt[nb], Hc[nb]};
    }
}

__device__ __forceinline__ void attn_item(const ArgView a, LAS unsigned char* wlds, int item, int lane) {
    lane = (int)__builtin_amdgcn_mbcnt_hi(~0u, __builtin_amdgcn_mbcnt_lo(~0u, 0u)); asm volatile("" : "+v"(lane));
    unsigned char* ws = a.ws();
    const int b = item >> 10, h = (item >> 7) & 7, qi = item & 127;
    const int n = lane & 31, hi = lane >> 5;
    const bf16_t* Pb = (const bf16_t*)(ws + WS_PROJ) + (size_t)b * SEQ * NPROJ;
    bf16_t* YMIX = (bf16_t*)(ws + WS_YMIX);
    bf16x8 qf[4];
#pragma unroll
    for (int ks = 0; ks < 4; ++ks) qf[ks] = *(const bf16x8*)(Pb + (size_t)(32 * qi + n) * NPROJ + 1024 + 64 * h + 16 * ks + 8 * hi);
    f32x16 o0 = {}, o1 = {}; float carry = 0.f;
    for (int kt = qi; kt >= 0; --kt) {
        bf16x8 kf[4];
#pragma unroll
        for (int ks = 0; ks < 4; ++ks) kf[ks] = *(const bf16x8*)(Pb + (size_t)(32 * kt + n) * NPROJ + 1536 + 64 * h + 16 * ks + 8 * hi);
#pragma unroll
        for (int j = 0; j < 4; ++j) { const int idx = lane + 64 * j, key = idx >> 3, piece = idx & 7;
            const u32x4 v = *(const u32x4*)(Pb + (size_t)(32 * kt + key) * NPROJ + 2048 + 64 * h + 8 * piece);
            *(LAS u32x4*)(wlds + key * 144 + piece * 16) = v; }
        f32x16 s = {};
#pragma unroll
        for (int ks = 0; ks < 4; ++ks) s = __builtin_amdgcn_mfma_f32_32x32x16_bf16(kf[ks], qf[ks], s, 0, 0, 0);
        const bool diag = (kt == qi);
        float lk[16], zl[16];
#pragma unroll
        for (int i = 0; i < 16; ++i) { const float z = s[i] * 0.125f; const bool valid = !diag || (crow(i, hi) < n);
            const float sp = fmaxf(z, 0.f) + LN2 * flog2(1.f + fexp2(-fabsf(z) * LOG2E));
            lk[i] = valid ? -sp : 0.f; zl[i] = valid ? (z - sp) : -INFINITY; }
        float T[4], oT[4], after[4];
#pragma unroll
        for (int g = 0; g < 4; ++g) T[g] = (lk[4 * g] + lk[4 * g + 1]) + (lk[4 * g + 2] + lk[4 * g + 3]);
#pragma unroll
        for (int g = 0; g < 4; ++g) oT[g] = __shfl_xor(T[g], 32);
        float Gs = 0.f;
#pragma unroll
        for (int g = 3; g >= 0; --g) { after[g] = Gs + (hi ? 0.f : oT[g]); Gs += T[g] + oT[g]; }
        float w[16];
#pragma unroll
        for (int g = 0; g < 4; ++g) { float suf = carry + after[g];
#pragma unroll
            for (int j = 3; j >= 0; --j) { const int i = 4 * g + j; w[i] = fexp2((zl[i] + suf) * LOG2E); suf += lk[i]; } }
        carry += Gs;
        bf16x8 pf[2];
#pragma unroll
        for (int s2 = 0; s2 < 2; ++s2) { u32x4 pw; pw.x = pk2(w[8 * s2], w[8 * s2 + 1]); pw.y = pk2(w[8 * s2 + 2], w[8 * s2 + 3]); pw.z = pk2(w[8 * s2 + 4], w[8 * s2 + 5]); pw.w = pk2(w[8 * s2 + 6], w[8 * s2 + 7]);
            pf[s2] = __builtin_bit_cast(bf16x8, pw); }
        LDS_WAIT();
#pragma unroll
        for (int d0 = 0; d0 < 2; ++d0)
#pragma unroll
            for (int s2 = 0; s2 < 2; ++s2) { bf16x8 vf;
#pragma unroll
                for (int e = 0; e < 2; ++e)
#pragma unroll
                    for (int j = 0; j < 4; ++j) vf[4 * e + j] = *(const LAS short*)(wlds + (16 * s2 + 4 * hi + j + 8 * e) * 144 + (32 * d0 + n) * 2);
                if (d0 == 0) o0 = __builtin_amdgcn_mfma_f32_32x32x16_bf16(vf, pf[s2], o0, 0, 0, 0); else o1 = __builtin_amdgcn_mfma_f32_32x32x16_bf16(vf, pf[s2], o1, 0, 0, 0); }
        LDS_WAIT();
        if (__all(carry < -104.0f)) break;
    }
    bf16_t* orow = YMIX + ((size_t)b * SEQ + 32 * qi + n) * 1024 + 512 + 64 * h;
#pragma unroll
    for (int g = 0; g < 4; ++g) { u32x2 w0, w1; w0.x = pk2(o0[4 * g], o0[4 * g + 1]); w0.y = pk2(o0[4 * g + 2], o0[4 * g + 3]); w1.x = pk2(o1[4 * g], o1[4 * g + 1]); w1.y = pk2(o1[4 * g + 2], o1[4 * g + 3]);
        *(u32x2*)(orow + 8 * g + 4 * hi) = w0; *(u32x2*)(orow + 32 + 8 * g + 4 * hi) = w1; }
}

__device__ __forceinline__ void conv_phase(const ArgView a, LAS unsigned char* lds, int wave, int lane) {
    lane = (int)__builtin_amdgcn_mbcnt_hi(~0u, __builtin_amdgcn_mbcnt_lo(~0u, 0u)); asm volatile("" : "+v"(lane));
    unsigned char* ws = a.ws();
    const bf16_t* GL = (const bf16_t*)(ws + WS_GL); bf16_t* CV = (bf16_t*)(ws + WS_CV);
    const int c = 128 * wave + 2 * lane;
    f32x2 wk[31];
#pragma unroll
    for (int k = 0; k < 31; ++k) wk[k] = *(const f32x2*)(a.in(14) + k * 1024 + c);
    const f32x2 bb = *(const f32x2*)(a.in(15) + c);
    LAS float* CT = (LAS float*)lds;
    for (int tile = LB(); tile < M / 32; tile += gridDim.x) {
        const int b = tile >> 7, t0 = (tile & 127) * 32; const bf16_t* G = GL + (size_t)b * SEQ * 1024 + c;
        unsigned X[38];
#pragma unroll
        for (int i = 0; i < 30; ++i) { const int t = t0 - 30 + i; X[i] = (t >= 0) ? *(const unsigned*)(G + (size_t)t * 1024) : 0u; }
#pragma unroll 1
        for (int ch = 0; ch < 4; ++ch) {
#pragma unroll
            for (int j = 0; j < 8; ++j) X[30 + j] = *(const unsigned*)(G + (size_t)(t0 + 8 * ch + j) * 1024);
            f32x2 acc[8];
#pragma unroll
            for (int j = 0; j < 8; ++j) acc[j] = bb;
#pragma unroll
            for (int i = 0; i < 38; ++i) { const f32x2 xv = (f32x2){bf_lo(X[i]), bf_hi(X[i])};
#pragma unroll
                for (int j = 0; j < 8; ++j) { const int k = i - j; if (k >= 0 && k <= 30) acc[j] += wk[k] * xv; } }
#pragma unroll
            for (int j = 0; j < 8; ++j) *(LAS f32x2*)(CT + (8 * ch + j) * 1024 + c) = acc[j];
#pragma unroll
            for (int i = 0; i < 30; ++i) X[i] = X[i + 8];
        }
        __syncthreads();
#pragma unroll 1
        for (int tt = 0; tt < 4; ++tt) { const int tok = 4 * wave + tt; const size_t m = (size_t)b * SEQ + t0 + tok;
            f32x4 v[4]; float s = 0.f;
#pragma unroll
            for (int j = 0; j < 4; ++j) { v[j] = *(const LAS f32x4*)(CT + tok * 1024 + 4 * lane + 256 * j); s += (v[j].x + v[j].y) + (v[j].z + v[j].w); }
            const float mean = wave_sum(s) * (1.0f / 1024.0f); float s2 = 0.f;
#pragma unroll
            for (int j = 0; j < 4; ++j) { v[j] = v[j] - mean; s2 += (v[j].x * v[j].x + v[j].y * v[j].y) + (v[j].z * v[j].z + v[j].w * v[j].w); }
            const float rstd = rsqrtf(wave_sum(s2) * (1.0f / 1024.0f) + LN_EPS);
#pragma unroll
            for (int j = 0; j < 4; ++j) { const f32x4 g = *(const f32x4*)(a.in(16) + 4 * lane + 256 * j), bt = *(const f32x4*)(a.in(17) + 4 * lane + 256 * j);
                f32x4 y = v[j] * rstd * g + bt;
#pragma unroll
                for (int e = 0; e < 4; ++e) y[e] = y[e] * fsigmoid(y[e]);
                u32x2 w; w.x = pk2(y[0], y[1]); w.y = pk2(y[2], y[3]); *(u32x2*)(CV + m * 1024 + 4 * lane + 256 * j) = w; }
        }
        __syncthreads();
    }
}

#define XB_TMO      128
#define XB_XCNT(j)  (256  + 64 * (j))
#define XB_XSUB(j)  (1280 + 64 * (j))
#define XB_XGEN(j)  (2304 + 64 * (j))
#define XB_TOP      3328
#define XB_TOPGEN   3392
#define XCD_BAR_WORDS 3456
#define XB_SPIN_CAP (1u << 18)

__device__ __forceinline__ unsigned xb_ld(unsigned* p)              { return __hip_atomic_load(p, __ATOMIC_RELAXED, __HIP_MEMORY_SCOPE_AGENT); }
__device__ __forceinline__ unsigned xb_add(unsigned* p, unsigned v) { return __hip_atomic_fetch_add(p, v, __ATOMIC_RELAXED, __HIP_MEMORY_SCOPE_AGENT); }
__device__ __forceinline__ unsigned xb_xcc_id() { return (unsigned)__builtin_amdgcn_s_getreg((3 << 11) | 20) & 0xFu; }
#define XB_SPIN(cond, bar) do { unsigned _sp = 0; while (cond) { __builtin_amdgcn_s_sleep(1); \
    if ((++_sp & 255u) == 0u) { if (xb_ld(&(bar)[XB_TMO])) break; if (_sp > XB_SPIN_CAP) { atomicAdd(&(bar)[XB_TMO], 1u); break; } } } } while (0)

struct XcdBarrier {
    unsigned* bar; unsigned x;
    volatile LAS unsigned* st;
};

__device__ __forceinline__ XcdBarrier xcd_barrier_post(unsigned* bar, volatile LAS unsigned* st) {
    XcdBarrier b; b.bar = bar; b.x = xb_xcc_id(); b.st = st;
    if (threadIdx.x == 0) (void)xb_add(&bar[XB_XCNT(b.x)], 1u);
    return b;
}
__device__ __forceinline__ void xcd_barrier_complete(unsigned* bar, unsigned x, unsigned& nloc, unsigned& nx) {
    const unsigned G = gridDim.x * gridDim.y * gridDim.z;
    unsigned sum, cnt, mine, sp = 0u;
    for (;;) {
        sum = 0u; cnt = 0u; mine = 0u;
#pragma unroll
        for (unsigned j = 0; j < 16; ++j) { const unsigned c = xb_ld(&bar[XB_XCNT(j)]); sum += c; cnt += (c > 0u) ? 1u : 0u; mine = (j == x) ? c : mine; }
        if (sum == G) break;
        __builtin_amdgcn_s_sleep(1);
        if ((++sp & 255u) == 0u) { if (xb_ld(&bar[XB_TMO])) break; if (sp > XB_SPIN_CAP) { atomicAdd(&bar[XB_TMO], 1u); break; } }
    }
    nloc = mine > 0u ? mine : 1u; nx = cnt > 0u ? cnt : 1u;
}

__device__ __forceinline__ void xcd_barrier(const XcdBarrier& b) {
    asm volatile("s_waitcnt vmcnt(0)" ::: "memory");
    __syncthreads();
    if (threadIdx.x == 0) {
        unsigned* bar = b.bar;
        __builtin_amdgcn_s_waitcnt(0);
        unsigned nloc = b.st[0], nx = b.st[1];
        if (nloc == 0u) { xcd_barrier_complete(bar, b.x, nloc, nx); b.st[0] = nloc; b.st[1] = nx; }
        const unsigned old = xb_add(&bar[XB_XSUB(b.x)], 1u);
        const unsigned gen = old / nloc;
        if (old + 1u == (gen + 1u) * nloc) {
            __builtin_amdgcn_fence(__ATOMIC_RELEASE, "agent");
            asm volatile("s_waitcnt vmcnt(0)" ::: "memory");
            const unsigned og = xb_add(&bar[XB_TOP], 1u);
            const unsigned tg = og / nx;
            if (og + 1u == (tg + 1u) * nx) xb_add(&bar[XB_TOPGEN], 1u);
            else XB_SPIN(xb_ld(&bar[XB_TOPGEN]) == tg, bar);
            __builtin_amdgcn_fence(__ATOMIC_ACQUIRE, "agent");
            xb_add(&bar[XB_XGEN(b.x)], 1u);
            asm volatile("s_waitcnt vmcnt(0)" ::: "memory");
        } else {
            XB_SPIN(xb_ld(&bar[XB_XGEN(b.x)]) == gen, bar);
            __builtin_amdgcn_fence(__ATOMIC_ACQUIRE, "agent");
            asm volatile("s_waitcnt vmcnt(0)" ::: "memory");
        }
    }
    __syncthreads();
}

__global__ void __launch_bounds__(NWAVES * 64, 2) trunk_fwd(Args kargs) {
    extern __shared__ __attribute__((aligned(16))) unsigned char lds_raw[];
    cg::grid_group grid = cg::this_grid();
    LAS unsigned char* lds = (LAS unsigned char*)lds_raw;
    const int wave = __builtin_amdgcn_readfirstlane((int)threadIdx.x >> 6); int lane = 0;
    const int G = gridDim.x, gw = blockIdx.x * NWAVES + wave, NGW = G * NWAVES;
    LAS unsigned char* wlds = lds + wave * 16384;
    volatile LAS unsigned* MISC = (volatile LAS unsigned*)(lds + MISC_OFF);
    if (threadIdx.x < 32) MISC[threadIdx.x] = 0u;
    __syncthreads();
    XcdBarrier bar = xcd_barrier_post((unsigned*)(argview().ws() + WS_BAR), MISC + 8);
#define GRID_BAR() xcd_barrier(bar)

    prologue(argview(), lds, wave, lane);
    grid.sync();
#pragma unroll 1
    for (int L = 0; L < 2; ++L) {
        if (L == 0) {
            { const ArgView a = argview(); unsigned char* ws = a.ws();
              pg8::Gemm g{(const bf16_t*)(ws + WS_XB), (const bf16_t*)(ws + WS_WIN), M, NPROJ, D}; pg8::StaticOrder S; S.init(M, NPROJ, LG(), LB());
              pg8::EpiScale<0> E{(bf16_t*)(ws + WS_PROJ), NPROJ, (const float*)(ws + WS_SS)};
              pg8::gemm_phase<pg8::EpiScale<0>, pg8::StaticOrder, true, true>(lds, g, S, E, wave); }
            GRID_BAR();
            { const int gwl = LB() * NWAVES + wave, ngw = LG() * NWAVES;
              for (int it = gwl; it < 2048; it += ngw) lru_item<1>(argview(), wlds, it, lane);
              for (int it = gwl; it < 4096; it += ngw) attn_item(argview(), wlds, it, lane); }
            GRID_BAR();
            { const int gwl = LB() * NWAVES + wave, ngw = LG() * NWAVES;
              for (int it = gwl; it < 2048; it += ngw) lru_item<2>(argview(), wlds, it, lane);
              for (int it = 4096 + gwl; it < 8192; it += ngw) attn_item(argview(), wlds, it, lane); }
            GRID_BAR();
        } else {
            { const ArgView a = argview(); unsigned char* ws = a.ws();
              pg8::Gemm g{(const bf16_t*)(ws + WS_XB), (const bf16_t*)(ws + WS_PW1), M, 2048, D}; pg8::StaticOrder S; S.init(M, 2048, LG(), LB());
              pg8::EpiGlu E{(bf16_t*)(ws + WS_GL), (const float*)(ws + WS_SS) + 2 * M, a.in(13)};
              pg8::gemm_phase<pg8::EpiGlu, pg8::StaticOrder, true, true>(lds, g, S, E, wave); }
            GRID_BAR();
            conv_phase(argview(), lds, wave, lane);
            GRID_BAR();
        }
        { const ArgView a = argview(); unsigned char* ws = a.ws();
          pg8::Gemm g{(const bf16_t*)(ws + (L == 0 ? WS_YMIX : WS_CV)), (const bf16_t*)(ws + (L == 0 ? WS_WOUT : WS_PW2)), M, D, D}; pg8::StaticOrder S; S.init(M, D, LG(), LB());
          pg8::EpiResid E{L == 0 ? a.in(0) : nullptr, (const bf16_t*)(ws + WS_XB), nullptr, (bf16_t*)(ws + WS_XB), L == 0 ? nullptr : a.in(19), (float*)(ws + WS_SS) + (2 * L + 1) * M};
          pg8::gemm_phase<pg8::EpiResid, pg8::StaticOrder, true, true>(lds, g, S, E, wave); }
        GRID_BAR();
        { const ArgView a = argview(); unsigned char* ws = a.ws();
          pg8::Gemm g{(const bf16_t*)(ws + WS_XB), (const bf16_t*)(ws + (L == 0 ? WS_W1A : WS_W1B)), M, FF, D}; pg8::StaticOrder S; S.init(M, FF, LG(), LB());
          pg8::EpiScale<1> E{(bf16_t*)(ws + WS_H), FF, (const float*)(ws + WS_SS) + (2 * L + 1) * M};
          pg8::gemm_phase<pg8::EpiScale<1>, pg8::StaticOrder, true, true>(lds, g, S, E, wave); }
        GRID_BAR();
        { const ArgView a = argview(); unsigned char* ws = a.ws();
          pg8::Gemm g{(const bf16_t*)(ws + WS_H), (const bf16_t*)(ws + (L == 0 ? WS_W2A : WS_W2B)), M, D, FF}; pg8::StaticOrder S; S.init(M, D, LG(), LB());
          pg8::EpiResid E{nullptr, (const bf16_t*)(ws + WS_XB), L == 0 ? nullptr : a.out(), (bf16_t*)(ws + WS_XB), nullptr, (float*)(ws + WS_SS) + (2 * L + 2) * M};
          pg8::gemm_phase<pg8::EpiResid, pg8::StaticOrder, true, true>(lds, g, S, E, wave); }
        GRID_BAR();
    }
    { const ArgView a = argview(); const float* SS = (const float*)(a.ws() + WS_SS); float* out = a.out(); const float* fg = a.in(23);
      lane = (int)__builtin_amdgcn_mbcnt_hi(~0u, __builtin_amdgcn_mbcnt_lo(~0u, 0u));
      for (int m = gw; m < M; m += NGW) {
        const float rs = rsqrtf(SS[4 * M + m] * (1.0f / 1024.0f) + RMS_EPS);
        f32x4* xr = (f32x4*)(out + (size_t)m * D) + lane; const f32x4* gr = (const f32x4*)fg + lane;
#pragma unroll
        for (int j = 0; j < 4; ++j) xr[64 * j] = xr[64 * j] * rs * gr[64 * j];
      } }
}

extern "C" void kernel_launch(void* const* d_in, const int* in_sizes, int n_in, void* d_out, int out_size, void* d_ws, size_t ws_size, hipStream_t stream) {
    static int grid = 0;
    if (grid == 0) {
        if (n_in != 24 || in_sizes[0] != M * D || out_size != M * D || ws_size < WS_END) { fprintf(stderr, "kernel_launch: unexpected shapes (n_in %d, ws %zu)\n", n_in, ws_size); grid = -1; return; }
        int dev = 0, cus = 0, per_cu = 0;
        hipGetDevice(&dev); hipDeviceGetAttribute(&cus, hipDeviceAttributeMultiprocessorCount, dev);
        hipFuncSetAttribute((const void*)trunk_fwd, hipFuncAttributeMaxDynamicSharedMemorySize, LDS_BYTES);
        hipOccupancyMaxActiveBlocksPerMultiprocessor(&per_cu, (const void*)trunk_fwd, NWAVES * 64, LDS_BYTES);
        if (per_cu < 1) per_cu = 1;
        (void)hipGetLastError();
        grid = cus * per_cu;
    }
    if (grid < 0) return;
    if (hipMemsetAsync((char*)d_ws + WS_BAR, 0, 16384, stream) != hipSuccess) { fprintf(stderr, "memset failed\n"); return; }
    Args a{};
    for (int i = 0; i < 24; ++i) a.in[i] = (const float*)d_in[i];
    a.out = (float*)d_out; a.ws = (unsigned char*)d_ws;
    void* args[] = {&a};
    hipError_t e = hipLaunchCooperativeKernel((const void*)trunk_fwd, dim3(grid), dim3(NWAVES * 64), args, LDS_BYTES, stream);
    if (e != hipSuccess) fprintf(stderr, "cooperative launch failed: %s (grid %d)\n", hipGetErrorString(e), grid);
}
```

```cpp
#include <hip/hip_runtime.h>
#include <hip/hip_cooperative_groups.h>
#include <cstdio>
#include <cstdint>
namespace cg = cooperative_groups;
namespace pg8 {
#define PG8_LAS __attribute__((address_space(3)))
typedef unsigned short bf16_t;
typedef short bf16x8 __attribute__((ext_vector_type(8)));
typedef float f32x4 __attribute__((ext_vector_type(4)));
typedef unsigned u32x4 __attribute__((ext_vector_type(4)));
constexpr int BM = 256, BK = 64, HALF = 128, HTB = HALF * BK * 2  , STAGE_BYTES = 8 * HTB, NXCD = 8, WGM = 8;

__host__ __device__ __forceinline__ int lds_byte(int r, int c) { const int st = (r >> 4) * 2 + (c >> 5), rr = r & 15, cc = c & 31, ob = rr * 64 + cc * 2; return st * 1024 + (ob ^ (((ob >> 9) & 1) << 5)); }
__host__ __device__ __forceinline__ void stage_rc(int b, int& R, int& C) { const int st = b / 1024, sb = b % 1024, swz = sb ^ (((sb >> 9) & 1) << 5); R = (st >> 1) * 16 + swz / 64; C = (st & 1) * 32 + (swz % 64) / 2; }
__host__ __device__ __forceinline__ int perm32(int rho) { const int n = rho >> 4, i = rho & 15; return 8 * (i >> 2) + 4 * n + (i & 3); }

struct Unit { int pm, pn; };
struct Gemm { const bf16_t* A; const bf16_t* Bt; int M, N, K; };

struct StaticOrder {
    int nM, nN, nwg, G, c;
    __host__ __device__ void init(int M, int N, int G_, int c_) { nM = M / BM; nN = N / BM; nwg = nM * nN; G = G_; c = c_; }
    __host__ __device__ bool next(int i, Unit& u) const {
        const long L = (long)i * G + c; if (L >= nwg) return false;
        int wgid = (int)L; { const int q = nwg / NXCD, r = nwg % NXCD, xcd = wgid % NXCD, off = wgid / NXCD; wgid = (xcd < r ? xcd * (q + 1) : r * (q + 1) + (xcd - r) * q) + off; }
        const int nig = WGM * nN, gid = wgid / nig, fm = gid * WGM, gsz = (nM - fm) < WGM ? (nM - fm) : WGM;
        u.pm = fm + ((wgid % nig) % gsz); u.pn = (wgid % nig) / gsz; return true;
    }
    __device__ __forceinline__ void a_ready(const Unit&) const {}
    __device__ __forceinline__ void done(const Unit&) const {}
};

__device__ __forceinline__ unsigned cvt_pk_bf16(float lo, float hi) { unsigned r; asm volatile("v_cvt_pk_bf16_f32 %0, %1, %2" : "=v"(r) : "v"(lo), "v"(hi)); return r; }
__device__ __forceinline__ float fast_exp(float x) { return __builtin_amdgcn_exp2f(x * 1.4426950408889634f); }
__device__ __forceinline__ float fast_sigmoid(float x) { return __builtin_amdgcn_rcpf(1.f + fast_exp(-x)); }
constexpr float RMS_EPS_ = 1e-6f;
template <int ACT> struct EpiScale {
    static constexpr bool PERM = true, AFTER_DRAIN = false;
    bf16_t* O; int ldc; const float* ss;
    __device__ __forceinline__ void operator()(const f32x4 (&acc)[2][2][4][2], const Unit& u, int wr, int wc, int fr, int fq) const {
        const int row0 = u.pm * BM + wr * 64 + fr, col0 = u.pn * BM + wc * 32 + 8 * fq;
#pragma unroll
        for (int ai = 0; ai < 2; ++ai)
#pragma unroll
            for (int m = 0; m < 4; ++m) { const int row = row0 + ai * HALF + m * 16; const float rs = rsqrtf(ss[row] * (1.0f / 1024.0f) + RMS_EPS_);
                bf16_t* rowp = O + (size_t)row * ldc + col0;
#pragma unroll
                for (int bj = 0; bj < 2; ++bj) { f32x4 v0 = acc[ai][bj][m][0] * rs, v1 = acc[ai][bj][m][1] * rs;
                    if (ACT == 1) {
#pragma unroll
                        for (int e = 0; e < 4; ++e) { const float a0 = fmaxf(v0[e], 0.f), a1 = fmaxf(v1[e], 0.f); v0[e] = a0 * a0; v1[e] = a1 * a1; } }
                    u32x4 w; w.x = cvt_pk_bf16(v0[0], v0[1]); w.y = cvt_pk_bf16(v0[2], v0[3]); w.z = cvt_pk_bf16(v1[0], v1[1]); w.w = cvt_pk_bf16(v1[2], v1[3]);
                    *(u32x4*)(rowp + bj * HALF) = w; } }
    }
};
struct EpiGlu {
    static constexpr bool PERM = true, AFTER_DRAIN = false;
    bf16_t* O; const float* ss; const float* bias;
    __device__ __forceinline__ void operator()(const f32x4 (&acc)[2][2][4][2], const Unit& u, int wr, int wc, int fr, int fq) const {
        const int row0 = u.pm * BM + wr * 64 + fr, ch0 = u.pn * HALF + wc * 32 + 8 * fq;
        f32x4 bv[2], bg[2];
#pragma unroll
        for (int n = 0; n < 2; ++n) { bv[n] = *(const f32x4*)(bias + ch0 + 4 * n); bg[n] = *(const f32x4*)(bias + 1024 + ch0 + 4 * n); }
#pragma unroll
        for (int ai = 0; ai < 2; ++ai)
#pragma unroll
            for (int m = 0; m < 4; ++m) { const int row = row0 + ai * HALF + m * 16; const float rs = rsqrtf(ss[row] * (1.0f / 1024.0f) + RMS_EPS_);
                f32x4 o[2];
#pragma unroll
                for (int n = 0; n < 2; ++n) { const f32x4 v = acc[ai][0][m][n] * rs + bv[n], g = acc[ai][1][m][n] * rs + bg[n];
#pragma unroll
                    for (int e = 0; e < 4; ++e) o[n][e] = v[e] * fast_sigmoid(g[e]); }
                u32x4 w; w.x = cvt_pk_bf16(o[0][0], o[0][1]); w.y = cvt_pk_bf16(o[0][2], o[0][3]); w.z = cvt_pk_bf16(o[1][0], o[1][1]); w.w = cvt_pk_bf16(o[1][2], o[1][3]);
                *(u32x4*)(O + (size_t)row * 1024 + ch0) = w; }
    }
};
struct EpiResid {
    static constexpr bool PERM = true, AFTER_DRAIN = false;
    const float* baseF; const bf16_t* baseB; float* outF; bf16_t* outB; const float* bias; float* ssout;
    __device__ __forceinline__ void operator()(const f32x4 (&acc)[2][2][4][2], const Unit& u, int wr, int wc, int fr, int fq) const {
        const int row0 = u.pm * BM + wr * 64 + fr, col0 = u.pn * BM + wc * 32 + 8 * fq;
        f32x4 bv[2][2];
#pragma unroll
        for (int bj = 0; bj < 2; ++bj)
#pragma unroll
            for (int n = 0; n < 2; ++n) bv[bj][n] = bias ? *(const f32x4*)(bias + col0 + bj * HALF + 4 * n) : (f32x4){0.f, 0.f, 0.f, 0.f};
#pragma unroll
        for (int ai = 0; ai < 2; ++ai)
#pragma unroll
            for (int m = 0; m < 4; ++m) { const int row = row0 + ai * HALF + m * 16; const size_t off = (size_t)row * 1024 + col0; float s = 0.f;
#pragma unroll
                for (int bj = 0; bj < 2; ++bj) {
                    f32x4 b0, b1;
                    if (baseF) { b0 = *(const f32x4*)(baseF + off + bj * HALF); b1 = *(const f32x4*)(baseF + off + bj * HALF + 4); }
                    else { const u32x4 r = *(const u32x4*)(baseB + off + bj * HALF);
                        b0 = (f32x4){__uint_as_float(r.x << 16), __uint_as_float(r.x & 0xffff0000u), __uint_as_float(r.y << 16), __uint_as_float(r.y & 0xffff0000u)};
                        b1 = (f32x4){__uint_as_float(r.z << 16), __uint_as_float(r.z & 0xffff0000u), __uint_as_float(r.w << 16), __uint_as_float(r.w & 0xffff0000u)}; }
                    const f32x4 v0 = acc[ai][bj][m][0] + bv[bj][0] + b0, v1 = acc[ai][bj][m][1] + bv[bj][1] + b1;
                    if (outF) { *(f32x4*)(outF + off + bj * HALF) = v0; *(f32x4*)(outF + off + bj * HALF + 4) = v1; }
                    else { u32x4 w; w.x = cvt_pk_bf16(v0[0], v0[1]); w.y = cvt_pk_bf16(v0[2], v0[3]); w.z = cvt_pk_bf16(v1[0], v1[1]); w.w = cvt_pk_bf16(v1[2], v1[3]);
                        *(u32x4*)(outB + off + bj * HALF) = w; }
                    s += (v0[0] * v0[0] + v0[1] * v0[1]) + (v0[2] * v0[2] + v0[3] * v0[3]) + (v1[0] * v1[0] + v1[1] * v1[1]) + (v1[2] * v1[2] + v1[3] * v1[3]); }
                s += __shfl_xor(s, 16); s += __shfl_xor(s, 32);
                if (fq == 0) unsafeAtomicAdd(ssout + row, s);
                asm volatile("" ::: "memory"); }
    }
};
template <class Epi, class Sched, bool ALIGN_EPI = false, bool SP2 = false>
__device__ __forceinline__ void gemm_phase(PG8_LAS unsigned char* lds, const Gemm g, const Sched& S, const Epi& E, const int wid_in) {
    int lane_l = (int)__builtin_amdgcn_mbcnt_hi(~0u, __builtin_amdgcn_mbcnt_lo(~0u, 0u)); asm volatile("" : "+v"(lane_l));
    int wid_l = wid_in; asm volatile("" : "+s"(wid_l));
    const int wid = wid_l, lane = lane_l, tid = wid * 64 + lane, wr = wid >> 2, wc = wid & 3, fr = lane & 15, fq = lane >> 4;
    const int K = g.K, nt = K / BK;
    unsigned voffA[2], voffB[2];
#pragma unroll
    for (int i = 0; i < 2; ++i) { int R, C; stage_rc(tid * 16 + i * 8192, R, C); const int Rb = Epi::PERM ? ((R & ~31) + perm32(R & 31)) : R;
        voffA[i] = (unsigned)(R * K + C) * 2u; voffB[i] = (unsigned)(Rb * K + C) * 2u; }
    const size_t kstep = (size_t)(BK * 2);
    const size_t hstep = (size_t)HALF * K * 2;
    const size_t tstep = 2 * hstep;
    const unsigned ldsw = (unsigned)wid * 1024u;
    const int aoff = lds_byte(wr * 64 + fr, fq * 8), boff = lds_byte(wc * 32 + fr, fq * 8);
#define PG8_SA(b, h) (((b) * 2 + (h)) * HTB)
#define PG8_SB(b, h) ((4 + (b) * 2 + (h)) * HTB)
#define PG8_STAGE(bufoff, gbase, voff) do { _Pragma("unroll") for (int _i = 0; _i < 2; ++_i) \
        __builtin_amdgcn_global_load_lds((const unsigned*)((const char*)(gbase) + (voff)[_i]), (PG8_LAS unsigned*)(lds + (bufoff) + ldsw + _i * 8192), 16, 0, 0); } while (0)
#define PG8_LDA(dst, b, h) do { _Pragma("unroll") for (int m = 0; m < 4; ++m) _Pragma("unroll") for (int k = 0; k < 2; ++k) dst[m][k] = *(const PG8_LAS bf16x8*)(lds + PG8_SA(b, h) + aoff + m * 2048 + k * 1024); } while (0)
#define PG8_LDB(dst, b, h) do { _Pragma("unroll") for (int n = 0; n < 2; ++n) _Pragma("unroll") for (int k = 0; k < 2; ++k) dst[n][k] = *(const PG8_LAS bf16x8*)(lds + PG8_SB(b, h) + boff + n * 2048 + k * 1024); } while (0)
#define PG8_MMA(ai, bj, At, Bt) do { __builtin_amdgcn_s_setprio(1); _Pragma("unroll") for (int m = 0; m < 4; ++m) _Pragma("unroll") for (int n = 0; n < 2; ++n) _Pragma("unroll") for (int k = 0; k < 2; ++k) \
        acc[ai][bj][m][n] = __builtin_amdgcn_mfma_f32_16x16x32_bf16(Bt[n][k], At[m][k], acc[ai][bj][m][n], 0, 0, 0); __builtin_amdgcn_s_setprio(0); } while (0)
#define PG8_WAIT_V(n) asm volatile("s_waitcnt vmcnt(" #n ")" ::: "memory")
#define PG8_WAIT_L(n) asm volatile("s_waitcnt lgkmcnt(" #n ")" ::: "memory")
#define PG8_BAR __builtin_amdgcn_s_barrier()
#define PG8_SCHED __builtin_amdgcn_sched_barrier(0)
    Unit cur, nxt; int ui = 0;
    if (!S.next(0, cur)) return;
    f32x4 acc[2][2][4][2];
#pragma unroll
    for (int a = 0; a < 2; ++a)
#pragma unroll
        for (int b = 0; b < 2; ++b)
#pragma unroll
            for (int m = 0; m < 4; ++m)
#pragma unroll
                for (int n = 0; n < 2; ++n) acc[a][b][m][n] = (f32x4){0.f, 0.f, 0.f, 0.f};
    bf16x8 At[4][2], B0[2][2], B1[2][2];
    const char* cA = (const char*)g.A + (size_t)cur.pm * tstep; const char* cB = (const char*)g.Bt + (size_t)cur.pn * tstep;
    S.a_ready(cur);
    if constexpr (SP2) {
        PG8_STAGE(PG8_SB(0, 0), cB, voffB); PG8_STAGE(PG8_SB(0, 1), cB + hstep, voffB); PG8_STAGE(PG8_SA(0, 0), cA, voffA); PG8_STAGE(PG8_SA(0, 1), cA + hstep, voffA);
        if (wr == 1) PG8_BAR;
        PG8_WAIT_V(2); PG8_BAR;
        PG8_STAGE(PG8_SB(1, 0), cB + kstep, voffB); PG8_STAGE(PG8_SA(1, 0), cA + kstep, voffA); PG8_STAGE(PG8_SB(1, 1), cB + hstep + kstep, voffB);
        PG8_WAIT_V(6); PG8_BAR;
    } else {
        PG8_STAGE(PG8_SB(0, 0), cB, voffB); PG8_STAGE(PG8_SA(0, 0), cA, voffA); PG8_STAGE(PG8_SB(0, 1), cB + hstep, voffB); PG8_STAGE(PG8_SA(0, 1), cA + hstep, voffA);
        if (wr == 1) PG8_BAR;
        PG8_WAIT_V(4); PG8_BAR;
        PG8_STAGE(PG8_SB(1, 0), cB + kstep, voffB); PG8_STAGE(PG8_SA(1, 0), cA + kstep, voffA); PG8_STAGE(PG8_SB(1, 1), cB + hstep + kstep, voffB);
        PG8_WAIT_V(6); PG8_BAR;
    }
    for (;;) {
        const bool has_next = S.next(ui + 1, nxt);
        const char* nA = has_next ? (const char*)g.A + (size_t)nxt.pm * tstep : cA; const char* nB = has_next ? (const char*)g.Bt + (size_t)nxt.pn * tstep : cB;
        for (int t = 0; t < nt; t += 2) {
            const bool last = (t == nt - 2);
            const char* a1 = cA + (size_t)(t + 1) * kstep;
            const char* a2 = last ? nA : cA + (size_t)(t + 2) * kstep; const char* b2 = last ? nB : cB + (size_t)(t + 2) * kstep;
            const char* a3 = a2 + kstep; const char* b3 = b2 + kstep;
            if (last && has_next) S.a_ready(nxt);
            if constexpr (SP2) {
            PG8_LDB(B0, 0, 0); PG8_LDB(B1, 0, 1); PG8_SCHED; PG8_LDA(At, 0, 0); PG8_STAGE(PG8_SA(1, 1), a1 + hstep, voffA);
            PG8_WAIT_V(8); PG8_WAIT_L(0); PG8_BAR; PG8_MMA(0, 0, At, B0); PG8_MMA(0, 1, At, B1); PG8_BAR; PG8_SCHED;
            PG8_LDA(At, 0, 1); PG8_STAGE(PG8_SB(0, 0), b2, voffB); PG8_STAGE(PG8_SB(0, 1), b2 + hstep, voffB); PG8_STAGE(PG8_SA(0, 0), a2, voffA);
            PG8_WAIT_V(8); PG8_WAIT_L(0); PG8_BAR; PG8_MMA(1, 0, At, B0); PG8_MMA(1, 1, At, B1); PG8_BAR; PG8_SCHED;
            PG8_LDB(B0, 1, 0); PG8_LDB(B1, 1, 1); PG8_SCHED; PG8_LDA(At, 1, 0); PG8_STAGE(PG8_SA(0, 1), a2 + hstep, voffA);
            PG8_WAIT_V(8); PG8_WAIT_L(0); PG8_BAR; PG8_MMA(0, 0, At, B0); PG8_MMA(0, 1, At, B1); PG8_BAR; PG8_SCHED;
            PG8_LDA(At, 1, 1); PG8_STAGE(PG8_SB(1, 0), b3, voffB); PG8_STAGE(PG8_SB(1, 1), b3 + hstep, voffB); PG8_STAGE(PG8_SA(1, 0), a3, voffA);
            PG8_WAIT_V(8); PG8_WAIT_L(0); PG8_BAR; PG8_MMA(1, 0, At, B0); PG8_MMA(1, 1, At, B1); PG8_BAR; PG8_SCHED;
            } else {
            PG8_LDB(B0, 0, 0); PG8_SCHED; PG8_LDA(At, 0, 0); PG8_STAGE(PG8_SA(1, 1), a1 + hstep, voffA);
            PG8_WAIT_L(8); PG8_BAR; PG8_WAIT_L(0); PG8_MMA(0, 0, At, B0); PG8_BAR; PG8_SCHED;
            PG8_LDB(B1, 0, 1); PG8_STAGE(PG8_SB(0, 0), b2, voffB);
            PG8_BAR; PG8_WAIT_L(0); PG8_MMA(0, 1, At, B1); PG8_BAR;
            PG8_LDA(At, 0, 1); PG8_STAGE(PG8_SA(0, 0), a2, voffA);
            PG8_BAR; PG8_WAIT_L(0); PG8_MMA(1, 0, At, B0); PG8_BAR; PG8_SCHED;
            PG8_STAGE(PG8_SB(0, 1), b2 + hstep, voffB);
            PG8_WAIT_V(6); PG8_BAR; PG8_MMA(1, 1, At, B1); PG8_BAR;
            PG8_LDB(B0, 1, 0); PG8_SCHED; PG8_LDA(At, 1, 0); PG8_STAGE(PG8_SA(0, 1), a2 + hstep, voffA);
            PG8_WAIT_L(8); PG8_BAR; PG8_WAIT_L(0); PG8_MMA(0, 0, At, B0); PG8_BAR; PG8_SCHED;
            PG8_LDB(B1, 1, 1); PG8_STAGE(PG8_SB(1, 0), b3, voffB);
            PG8_BAR; PG8_WAIT_L(0); PG8_MMA(0, 1, At, B1); PG8_BAR;
            PG8_LDA(At, 1, 1); PG8_STAGE(PG8_SA(1, 0), a3, voffA);
            PG8_BAR; PG8_WAIT_L(0); PG8_MMA(1, 0, At, B0); PG8_BAR; PG8_SCHED;
            PG8_STAGE(PG8_SB(1, 1), b3 + hstep, voffB);
            PG8_WAIT_V(6); PG8_BAR; PG8_MMA(1, 1, At, B1); PG8_BAR;
            }
        }
        if constexpr (ALIGN_EPI) { if (wr == 0) PG8_BAR; }
        if constexpr (!Epi::AFTER_DRAIN) { E(acc, cur, wr, wc, fr, fq); S.done(cur); }
        if (!has_next) break;
#pragma unroll
        for (int a = 0; a < 2; ++a)
#pragma unroll
            for (int b = 0; b < 2; ++b)
#pragma unroll
                for (int m = 0; m < 4; ++m)
#pragma unroll
                    for (int n = 0; n < 2; ++n) acc[a][b][m][n] = (f32x4){0.f, 0.f, 0.f, 0.f};
        cur = nxt; cA = nA; cB = nB; ++ui;
        if constexpr (ALIGN_EPI) { if (wr == 1) PG8_BAR; }
    }
    PG8_WAIT_V(0);
    if constexpr (!ALIGN_EPI) { if (wr == 0) PG8_BAR; }
    PG8_BAR;
    if constexpr (Epi::AFTER_DRAIN) { E.fused(acc, cur, wr, wc, fr, fq, lds, wid, lane); S.done(cur); }
#undef PG8_SA
#undef PG8_SB
#undef PG8_STAGE
#undef PG8_LDA
#undef PG8_LDB
#undef PG8_MMA
#undef PG8_WAIT_V
#undef PG8_WAIT_L
#undef PG8_BAR
#undef PG8_SCHED
}
}
using pg8::bf16_t; using pg8::bf16x8; using pg8::f32x4; using pg8::u32x4;
typedef float f32x16 __attribute__((ext_vector_type(16)));
typedef float f32x2 __attribute__((ext_vector_type(2)));
typedef unsigned u32x2 __attribute__((ext_vector_type(2)));
#define LAS __attribute__((address_space(3)))
constexpr int NWAVES = 8;
#define PROBE_P 1
#define PROBE_X 1
#define PROBE_C 1
constexpr int BATCH = 8, SEQ = 4096, D = 1024, M = BATCH * SEQ, FF = 4096, NPROJ = 2560;
constexpr float RMS_EPS = 1e-6f, LN_EPS = 1e-5f;
constexpr float LOG2E = 1.4426950408889634f, LN2 = 0.6931471805599453f;
constexpr size_t MiB = 1u << 20;
constexpr size_t WS_SS = 0;
constexpr size_t WS_BAR = 768 * 1024;
constexpr size_t WS_SUM = 1 * MiB;
constexpr size_t WS_WIN = 2 * MiB, WS_WOUT = 7 * MiB, WS_W1A = 9 * MiB, WS_W2A = 17 * MiB, WS_PW1 = 25 * MiB, WS_PW2 = 29 * MiB, WS_W1B = 31 * MiB, WS_W2B = 39 * MiB;
constexpr size_t WS_GA = 47 * MiB, WS_GX = 47 * MiB + 65536;
constexpr size_t WS_XB = 64 * MiB;
constexpr size_t WS_PROJ = 128 * MiB;
constexpr size_t WS_YMIX = 288 * MiB;
constexpr size_t WS_H = 128 * MiB;
constexpr size_t WS_GL = 128 * MiB;
constexpr size_t WS_CV = 192 * MiB;
constexpr size_t WS_END = 384 * MiB;
constexpr int MISC_OFF = 131072 + 320;
constexpr int LDS_BYTES = 147456;

#define LDS_WAIT() asm volatile("s_waitcnt lgkmcnt(0)" ::: "memory")
__device__ __forceinline__ float fexp2(float x) { return __builtin_amdgcn_exp2f(x); }
__device__ __forceinline__ float flog2(float x) { return __builtin_amdgcn_logf(x); }
__device__ __forceinline__ float fexp(float x) { return fexp2(x * LOG2E); }
__device__ __forceinline__ float fsigmoid(float x) { return __builtin_amdgcn_rcpf(1.f + fexp(-x)); }
__device__ __forceinline__ unsigned pk2(float lo, float hi) { return pg8::cvt_pk_bf16(lo, hi); }
__device__ __forceinline__ float bf_lo(unsigned u) { return __uint_as_float(u << 16); }
__device__ __forceinline__ float bf_hi(unsigned u) { return __uint_as_float(u & 0xffff0000u); }
__device__ __forceinline__ float bf1(bf16_t u) { return __uint_as_float((unsigned)u << 16); }
__device__ __forceinline__ int crow(int r, int hi) { return (r & 3) + 8 * (r >> 2) + 4 * hi; }
__device__ __forceinline__ float wave_sum(float v) {
#pragma unroll
    for (int o = 1; o < 64; o <<= 1) v += __shfl_xor(v, o);
    return v;
}

struct Args { const float* in[24]; float* out; unsigned char* ws; };
__device__ __forceinline__ int LB() { int b = (int)blockIdx.x; asm volatile("" : "+s"(b)); return b; }
__device__ __forceinline__ int LG() { int g = (int)gridDim.x; asm volatile("" : "+s"(g)); return g; }
#define AS4 __attribute__((address_space(4)))
struct ArgView { const AS4 unsigned char* kp;
    __device__ __forceinline__ const float* in(int i) const { return *(const float* const AS4*)(kp + 8 * i); }
    __device__ __forceinline__ float* out() const { return *(float* const AS4*)(kp + 192); }
    __device__ __forceinline__ unsigned char* ws() const { return *(unsigned char* const AS4*)(kp + 200); }
};
__device__ __forceinline__ ArgView argview() { const AS4 unsigned char* kp = (const AS4 unsigned char*)__builtin_amdgcn_kernarg_segment_ptr(); asm volatile("" : "+s"(kp)); return ArgView{kp}; }

__device__ __forceinline__ void p0_transpose_item(const float* W, int K, int N, bf16_t* WT, const float* gk, int glu_perm, LAS float* scr, int item, int lane) {
    const int nblk = N / 32, kb = item / nblk, nb = item % nblk, k0 = 64 * kb, n0 = 32 * nb;
    float wv[32];
#pragma unroll
    for (int i = 0; i < 32; ++i) wv[i] = W[(size_t)(k0 + 2 * i + (lane >> 5)) * N + n0 + (lane & 31)];
    if (gk) {
#pragma unroll
        for (int i = 0; i < 32; ++i) wv[i] *= gk[k0 + 2 * i + (lane >> 5)]; }
#pragma unroll
    for (int i = 0; i < 32; ++i) scr[(2 * i + (lane >> 5)) * 33 + (lane & 31)] = wv[i];
    LDS_WAIT();
    const int c = lane & 7;
#pragma unroll
    for (int j = 0; j < 4; ++j) { const int n = (lane >> 3) + 8 * j; const LAS float* s = scr + (8 * c) * 33 + n;
        u32x4 o; o.x = pk2(s[0 * 33], s[1 * 33]); o.y = pk2(s[2 * 33], s[3 * 33]); o.z = pk2(s[4 * 33], s[5 * 33]); o.w = pk2(s[6 * 33], s[7 * 33]);
        int nrow = n0 + n;
        if (glu_perm) nrow = (nrow < 1024) ? ((nrow >> 7) * 256 + (nrow & 127)) : ((((nrow - 1024) >> 7) * 256) + 128 + ((nrow - 1024) & 127));
        *(u32x4*)(WT + (size_t)nrow * K + k0 + 8 * c) = o; }
    LDS_WAIT();
}
__device__ __forceinline__ void prologue(const ArgView a, LAS unsigned char* lds, int wave, int lane) {
    lane = (int)__builtin_amdgcn_mbcnt_hi(~0u, __builtin_amdgcn_mbcnt_lo(~0u, 0u)); asm volatile("" : "+v"(lane));
    LAS float* scr = (LAS float*)(lds + wave * 16384);
    unsigned char* ws = a.ws();
    const int gw = blockIdx.x * NWAVES + wave, NGW = gridDim.x * NWAVES;
    constexpr int I_IN = 16 * 80, I_SQ = 16 * 32, I_UP = 16 * 128, I_DN = 64 * 32, I_P1 = 16 * 64, I_G = 16;
    constexpr int NITEMS = I_IN + I_SQ + I_UP + I_DN + I_P1 + I_SQ + I_UP + I_DN + I_G + I_G;
    for (int it = gw; it < NITEMS; it += NGW) {
        int r = it;
        if (r < I_IN) { p0_transpose_item(a.in(2), 1024, NPROJ, (bf16_t*)(ws + WS_WIN), a.in(1), 0, scr, r, lane); continue; } r -= I_IN;
        if (r < I_SQ) { p0_transpose_item(a.in(10), 1024, 1024, (bf16_t*)(ws + WS_WOUT), nullptr, 0, scr, r, lane); continue; } r -= I_SQ;
        if (r < I_UP) { p0_transpose_item(a.in(21), 1024, FF, (bf16_t*)(ws + WS_W1A), a.in(20), 0, scr, r, lane); continue; } r -= I_UP;
        if (r < I_DN) { p0_transpose_item(a.in(22), FF, 1024, (bf16_t*)(ws + WS_W2A), nullptr, 0, scr, r, lane); continue; } r -= I_DN;
        if (r < I_P1) { p0_transpose_item(a.in(12), 1024, 2048, (bf16_t*)(ws + WS_PW1), a.in(11), 1, scr, r, lane); continue; } r -= I_P1;
        if (r < I_SQ) { p0_transpose_item(a.in(18), 1024, 1024, (bf16_t*)(ws + WS_PW2), nullptr, 0, scr, r, lane); continue; } r -= I_SQ;
        if (r < I_UP) { p0_transpose_item(a.in(21) + (size_t)1024 * FF, 1024, FF, (bf16_t*)(ws + WS_W1B), a.in(20) + 1024, 0, scr, r, lane); continue; } r -= I_UP;
        if (r < I_DN) { p0_transpose_item(a.in(22) + (size_t)1024 * FF, FF, 1024, (bf16_t*)(ws + WS_W2B), nullptr, 0, scr, r, lane); continue; } r -= I_DN;
        if (r < I_G) { const int h = r >> 1; p0_transpose_item(a.in(5) + h * 4096, 64, 64, (bf16_t*)(ws + WS_GA) + h * 4096, nullptr, 0, scr, r & 1, lane); continue; } r -= I_G;
        { const int h = r >> 1; p0_transpose_item(a.in(7) + h * 4096, 64, 64, (bf16_t*)(ws + WS_GX) + h * 4096, nullptr, 0, scr, r & 1, lane); }
    }
    const float* x = a.in(0); bf16_t* XB = (bf16_t*)(ws + WS_XB); float* SS = (float*)(ws + WS_SS);
    for (int m0 = 4 * gw; m0 < M; m0 += 4 * NGW) {
        f32x4 v[4][4];
#pragma unroll
        for (int r = 0; r < 4; ++r)
#pragma unroll
            for (int j = 0; j < 4; ++j) v[r][j] = ((const f32x4*)(x + (size_t)(m0 + r) * D) + lane)[64 * j];
#pragma unroll
        for (int r = 0; r < 4; ++r) { u32x2* o8 = (u32x2*)(XB + (size_t)(m0 + r) * D) + lane; float s = 0.f;
#pragma unroll
            for (int j = 0; j < 4; ++j) { const f32x4 q = v[r][j]; s += (q.x * q.x + q.y * q.y) + (q.z * q.z + q.w * q.w); u32x2 w; w.x = pk2(q.x, q.y); w.y = pk2(q.z, q.w); o8[64 * j] = w; }
            s = wave_sum(s); if (lane == 0) SS[m0 + r] = s; }
    }
    for (int i = blockIdx.x * 512 + wave * 64 + lane; i < 4 * M; i += gridDim.x * 512) SS[M + i] = 0.f;
}

template <int PASS> __device__ __forceinline__ void lru_item(const ArgView a, LAS unsigned char* wlds, int item, int lane) {
    lane = (int)__builtin_amdgcn_mbcnt_hi(~0u, __builtin_amdgcn_mbcnt_lo(~0u, 0u)); asm volatile("" : "+v"(lane));
    unsigned char* ws = a.ws();
    const bf16_t* PROJ = (const bf16_t*)(ws + WS_PROJ); bf16_t* YMIX = (bf16_t*)(ws + WS_YMIX); float* SUM = (float*)(ws + WS_SUM);
    const int b = item >> 8, c128 = (item >> 3) & 31, h = item & 7;
    const int n = lane & 31, hi = lane >> 5, r8 = lane >> 3, cgp = lane & 7;
    LAS float* XC = (LAS float*)wlds;
    const bf16_t* GA = (const bf16_t*)(ws + WS_GA) + h * 4096; const bf16_t* GX = (const bf16_t*)(ws + WS_GX) + h * 4096;
    bf16x8 wa[2][4], wx[2][4];
#pragma unroll
    for (int nb = 0; nb < 2; ++nb)
#pragma unroll
        for (int ks = 0; ks < 4; ++ks) { wa[nb][ks] = *(const bf16x8*)(GA + (32 * nb + n) * 64 + 16 * ks + 8 * hi); wx[nb][ks] = *(const bf16x8*)(GX + (32 * nb + n) * 64 + 16 * ks + 8 * hi); }
    float ba[2], bx[2], ls8[2], Hc[2], Pt[2];
#pragma unroll
    for (int nb = 0; nb < 2; ++nb) { const int ch = 64 * h + 32 * nb + n; ba[nb] = -LOG2E * a.in(6)[ch]; bx[nb] = -LOG2E * a.in(8)[ch];
        const float lam = a.in(9)[ch]; ls8[nb] = -8.0f * LOG2E * (fmaxf(-lam, 0.f) + log1pf(expf(-fabsf(lam))));
        Hc[nb] = 0.f; Pt[nb] = 1.f; }
    if (PASS == 2) {
        for (int cc = 0; cc < c128; ++cc) {
#pragma unroll
            for (int nb = 0; nb < 2; ++nb) { const f32x2 ab = *(const f32x2*)(SUM + ((size_t)((b * 32 + cc) * 512 + 64 * h + 32 * nb + n)) * 2); Hc[nb] = ab.x * Hc[nb] + ab.y; } }
    }
    const bf16_t* Xr = PROJ + (size_t)b * SEQ * NPROJ + 512 + 64 * h + 8 * cgp;
#pragma unroll 1
    for (int sub = 0; sub < 4; ++sub) {
        const int t0 = 128 * c128 + 32 * sub;
        float cwv[4][8], cbv[8];
#pragma unroll
        for (int k = 0; k < 4; ++k) { const f32x4 w0 = *(const f32x4*)(a.in(3) + k * 512 + 64 * h + 8 * cgp), w1 = *(const f32x4*)(a.in(3) + k * 512 + 64 * h + 8 * cgp + 4);
#pragma unroll
            for (int e = 0; e < 4; ++e) { cwv[k][e] = w0[e]; cwv[k][4 + e] = w1[e]; } }
        { const f32x4 w0 = *(const f32x4*)(a.in(4) + 64 * h + 8 * cgp), w1 = *(const f32x4*)(a.in(4) + 64 * h + 8 * cgp + 4);
#pragma unroll
          for (int e = 0; e < 4; ++e) { cbv[e] = w0[e]; cbv[4 + e] = w1[e]; } }
        u32x4 xin[7];
#pragma unroll
        for (int i = 0; i < 7; ++i) { const int t = t0 + 4 * r8 - 3 + i; xin[i] = (t >= 0) ? *(const u32x4*)(Xr + (size_t)t * NPROJ) : (u32x4){0u, 0u, 0u, 0u}; }
#pragma unroll
        for (int j = 0; j < 4; ++j) { float o[8];
#pragma unroll
            for (int e = 0; e < 8; ++e) o[e] = cbv[e];
#pragma unroll
            for (int k = 0; k < 4; ++k) { const u32x4 xv = xin[j + k];
#pragma unroll
                for (int e2 = 0; e2 < 4; ++e2) { o[2 * e2] += cwv[k][2 * e2] * bf_lo(xv[e2]); o[2 * e2 + 1] += cwv[k][2 * e2 + 1] * bf_hi(xv[e2]); } }
            *(LAS f32x4*)(XC + (4 * r8 + j) * 68 + 8 * cgp) = (f32x4){o[0], o[1], o[2], o[3]};
            *(LAS f32x4*)(XC + (4 * r8 + j) * 68 + 8 * cgp + 4) = (f32x4){o[4], o[5], o[6], o[7]}; }
        LDS_WAIT();
        bf16x8 af[4];
#pragma unroll
        for (int ks = 0; ks < 4; ++ks) { const f32x4 lo = *(const LAS f32x4*)(XC + n * 68 + 16 * ks + 8 * hi), hv = *(const LAS f32x4*)(XC + n * 68 + 16 * ks + 8 * hi + 4);
            u32x4 w; w.x = pk2(lo[0], lo[1]); w.y = pk2(lo[2], lo[3]); w.z = pk2(hv[0], hv[1]); w.w = pk2(hv[2], hv[3]); af[ks] = __builtin_bit_cast(bf16x8, w); }
#pragma unroll
        for (int nb = 0; nb < 2; ++nb) {
            f32x16 accA = {}, accX = {};
#pragma unroll
            for (int ks = 0; ks < 4; ++ks) { accA = __builtin_amdgcn_mfma_f32_32x32x16_bf16(af[ks], wa[nb][ks], accA, 0, 0, 0); accX = __builtin_amdgcn_mfma_f32_32x32x16_bf16(af[ks], wx[nb][ks], accX, 0, 0, 0); }
            float av[16], iv[16];
#pragma unroll
            for (int i = 0; i < 16; ++i) { const float xv = XC[crow(i, hi) * 68 + 32 * nb + n];
                const float r = __builtin_amdgcn_rcpf(1.f + fexp2(accA[i] * (-LOG2E) + ba[nb])), ig = __builtin_amdgcn_rcpf(1.f + fexp2(accX[i] * (-LOG2E) + bx[nb]));
                const float la2 = ls8[nb] * r, aa = fexp2(la2), y = la2 * (2.0f * LN2);
                const float pl = -y * (1.f + y * (0.5f + y * (0.16666667f + y * (0.041666668f + y * 0.0083333338f))));
                const float m2 = (y > -0.25f) ? pl : (1.f - aa * aa);
                av[i] = aa; iv[i] = __builtin_amdgcn_sqrtf(fmaxf(m2, 0.f)) * (ig * xv); }
            float Ag[4], Bg[4], oA[4], oB[4];
#pragma unroll
            for (int g = 0; g < 4; ++g) { float A = av[4 * g], B = iv[4 * g];
#pragma unroll
                for (int j = 1; j < 4; ++j) { B = av[4 * g + j] * B + iv[4 * g + j]; A *= av[4 * g + j]; }
                Ag[g] = A; Bg[g] = B; }
#pragma unroll
            for (int g = 0; g < 4; ++g) { oA[g] = __shfl_xor(Ag[g], 32); oB[g] = __shfl_xor(Bg[g], 32); }
            float S = Hc[nb], st[4], P = Pt[nb];
#pragma unroll
            for (int g = 0; g < 4; ++g) { const float A0 = hi ? oA[g] : Ag[g], B0 = hi ? oB[g] : Bg[g], A1 = hi ? Ag[g] : oA[g], B1 = hi ? Bg[g] : oB[g];
                const float S1 = A0 * S + B0; st[g] = hi ? S1 : S; S = A1 * S1 + B1; P *= A0 * A1; }
            Hc[nb] = S; Pt[nb] = P;
            if (PASS == 2) {
                const size_t mrow = (size_t)b * SEQ + t0; const int ch = 64 * h + 32 * nb + n;
#pragma unroll
                for (int g = 0; g < 4; ++g) { float hh = st[g];
#pragma unroll
                    for (int j = 0; j < 4; ++j) { const int i = 4 * g + j; hh = av[i] * hh + iv[i];
                        const size_t mr = mrow + crow(i, hi); const float gt = bf1(PROJ[mr * NPROJ + ch]);
                        const float u2 = 1.5957691216057308f * (gt + 0.044715f * gt * gt * gt);
                        const float th = 1.f - 2.f * __builtin_amdgcn_rcpf(1.f + fexp(u2));
                        const float y = 0.5f * gt * (1.f + th) * hh;
                        YMIX[mr * 1024 + ch] = (bf16_t)(pk2(y, y) & 0xffffu); } }
            }
        }
        LDS_WAIT();
    }
    if (PASS == 1 && hi == 0) {
#pragma unroll
        for (int nb = 0; nb < 2; ++nb) *(f32x2*)(SUM + ((size_t)((b * 32 + c128) * 512 + 64 * h + 32 * nb + n)) * 2) = (f32x2){Pt[nb], Hc[nb]};
    }
}

__device__ __forceinline__ void attn_item(const ArgView a, LAS unsigned char* wlds, int item, int lane) {
    lane = (int)__builtin_amdgcn_mbcnt_hi(~0u, __builtin_amdgcn_mbcnt_lo(~0u, 0u)); asm volatile("" : "+v"(lane));
    unsigned char* ws = a.ws();
    const int b = item >> 10, h = (item >> 7) & 7, qi = item & 127;
    const int n = lane & 31, hi = lane >> 5;
    const bf16_t* Pb = (const bf16_t*)(ws + WS_PROJ) + (size_t)b * SEQ * NPROJ;
    bf16_t* YMIX = (bf16_t*)(ws + WS_YMIX);
    const bf16_t* Kl = Pb + (size_t)n * NPROJ + 1536 + 64 * h + 8 * hi;
    const bf16_t* Vl = Pb + (size_t)(lane >> 3) * NPROJ + 2048 + 64 * h + 8 * (lane & 7);
    const int vst = (lane >> 3) * 144 + (lane & 7) * 16;
    bf16x8 qf[4], kfN[4]; u32x4 vN[4];
#pragma unroll
    for (int ks = 0; ks < 4; ++ks) qf[ks] = *(const bf16x8*)(Pb + (size_t)(32 * qi + n) * NPROJ + 1024 + 64 * h + 16 * ks + 8 * hi);
#pragma unroll
    for (int ks = 0; ks < 4; ++ks) kfN[ks] = *(const bf16x8*)(Kl + (size_t)(32 * qi) * NPROJ + 16 * ks);
#pragma unroll
    for (int j = 0; j < 4; ++j) vN[j] = *(const u32x4*)(Vl + (size_t)(32 * qi + 8 * j) * NPROJ);
    f32x16 o0 = {}, o1 = {}; float carry = 1.f; int cur = 0;
    for (int kt = qi; kt >= 0; --kt) {
        bf16x8 kf[4];
#pragma unroll
        for (int ks = 0; ks < 4; ++ks) kf[ks] = kfN[ks];
        LAS unsigned char* vb = wlds + cur * 4608;
#pragma unroll
        for (int j = 0; j < 4; ++j) *(LAS u32x4*)(vb + vst + j * 8 * 144) = vN[j];
        asm volatile("" ::: "memory");
        if (kt > 0) {
#pragma unroll
            for (int ks = 0; ks < 4; ++ks) kfN[ks] = *(const bf16x8*)(Kl + (size_t)(32 * (kt - 1)) * NPROJ + 16 * ks);
#pragma unroll
            for (int j = 0; j < 4; ++j) vN[j] = *(const u32x4*)(Vl + (size_t)(32 * (kt - 1) + 8 * j) * NPROJ);
        }
        f32x16 s = {};
#pragma unroll
        for (int ks = 0; ks < 4; ++ks) s = __builtin_amdgcn_mfma_f32_32x32x16_bf16(kf[ks], qf[ks], s, 0, 0, 0);
        float kp[16], bt[16];
#pragma unroll
        for (int i = 0; i < 16; ++i) { const float e = fexp2(fminf(s[i] * (0.125f * LOG2E), 100.f)); kp[i] = __builtin_amdgcn_rcpf(1.f + e); bt[i] = e * kp[i]; }
        if (kt == qi) {
#pragma unroll
            for (int i = 0; i < 16; ++i) { const bool valid = crow(i, hi) < n; kp[i] = valid ? kp[i] : 1.f; bt[i] = valid ? bt[i] : 0.f; }
        }
        float T[4], oT[4], after[4];
#pragma unroll
        for (int g = 0; g < 4; ++g) T[g] = (kp[4 * g] * kp[4 * g + 1]) * (kp[4 * g + 2] * kp[4 * g + 3]);
#pragma unroll
        for (int g = 0; g < 4; ++g) oT[g] = __shfl_xor(T[g], 32);
        float Gs = 1.f;
#pragma unroll
        for (int g = 3; g >= 0; --g) { after[g] = hi ? Gs : Gs * oT[g]; Gs *= T[g] * oT[g]; }
        float w[16];
#pragma unroll
        for (int g = 0; g < 4; ++g) { float suf = carry * after[g];
#pragma unroll
            for (int j = 3; j >= 0; --j) { const int i = 4 * g + j; w[i] = bt[i] * suf; suf *= kp[i]; } }
        carry *= Gs;
        bf16x8 pf[2];
#pragma unroll
        for (int s2 = 0; s2 < 2; ++s2) { u32x4 pw; pw.x = pk2(w[8 * s2], w[8 * s2 + 1]); pw.y = pk2(w[8 * s2 + 2], w[8 * s2 + 3]); pw.z = pk2(w[8 * s2 + 4], w[8 * s2 + 5]); pw.w = pk2(w[8 * s2 + 6], w[8 * s2 + 7]);
            pf[s2] = __builtin_bit_cast(bf16x8, pw); }
#pragma unroll
        for (int d0 = 0; d0 < 2; ++d0)
#pragma unroll
            for (int s2 = 0; s2 < 2; ++s2) { bf16x8 vf;
#pragma unroll
                for (int e = 0; e < 2; ++e)
#pragma unroll
                    for (int j = 0; j < 4; ++j) vf[4 * e + j] = *(const LAS short*)(vb + (16 * s2 + 4 * hi + j + 8 * e) * 144 + (32 * d0 + n) * 2);
                if (d0 == 0) o0 = __builtin_amdgcn_mfma_f32_32x32x16_bf16(vf, pf[s2], o0, 0, 0, 0); else o1 = __builtin_amdgcn_mfma_f32_32x32x16_bf16(vf, pf[s2], o1, 0, 0, 0); }
        asm volatile("" ::: "memory");
        cur ^= 1;
        if (__all(carry < 1e-30f)) break;
    }
    LDS_WAIT();
    bf16_t* orow = YMIX + ((size_t)b * SEQ + 32 * qi + n) * 1024 + 512 + 64 * h;
#pragma unroll
    for (int g = 0; g < 4; ++g) { u32x2 w0, w1; w0.x = pk2(o0[4 * g], o0[4 * g + 1]); w0.y = pk2(o0[4 * g + 2], o0[4 * g + 3]); w1.x = pk2(o1[4 * g], o1[4 * g + 1]); w1.y = pk2(o1[4 * g + 2], o1[4 * g + 3]);
        *(u32x2*)(orow + 8 * g + 4 * hi) = w0; *(u32x2*)(orow + 32 + 8 * g + 4 * hi) = w1; }
}

__device__ __forceinline__ void conv_phase(const ArgView a, LAS unsigned char* lds, int wave, int lane) {
    lane = (int)__builtin_amdgcn_mbcnt_hi(~0u, __builtin_amdgcn_mbcnt_lo(~0u, 0u)); asm volatile("" : "+v"(lane));
    unsigned char* ws = a.ws();
    const bf16_t* GL = (const bf16_t*)(ws + WS_GL); bf16_t* CV = (bf16_t*)(ws + WS_CV);
    const int c = 128 * wave + 2 * lane;
    f32x2 wk[31];
#pragma unroll
    for (int k = 0; k < 31; ++k) wk[k] = *(const f32x2*)(a.in(14) + k * 1024 + c);
    const f32x2 bb = *(const f32x2*)(a.in(15) + c);
    LAS float* CT = (LAS float*)lds;
    for (int tile = LB(); tile < M / 32; tile += gridDim.x) {
        const int b = tile >> 7, t0 = (tile & 127) * 32; const bf16_t* G = GL + (size_t)b * SEQ * 1024 + c;
        unsigned X[38];
#pragma unroll
        for (int i = 0; i < 30; ++i) { const int t = t0 - 30 + i; X[i] = (t >= 0) ? *(const unsigned*)(G + (size_t)t * 1024) : 0u; }
#pragma unroll
        for (int j = 0; j < 8; ++j) X[30 + j] = *(const unsigned*)(G + (size_t)(t0 + j) * 1024);
#pragma unroll 1
        for (int ch = 0; ch < 4; ++ch) {
            unsigned NX[8];
            if (ch < 3) {
#pragma unroll
                for (int j = 0; j < 8; ++j) NX[j] = *(const unsigned*)(G + (size_t)(t0 + 8 * ch + 8 + j) * 1024); }
            else {
#pragma unroll
                for (int j = 0; j < 8; ++j) NX[j] = 0u; }
            f32x2 acc[8];
#pragma unroll
            for (int j = 0; j < 8; ++j) acc[j] = bb;
#pragma unroll
            for (int i = 0; i < 38; ++i) { const f32x2 xv = (f32x2){bf_lo(X[i]), bf_hi(X[i])};
#pragma unroll
                for (int j = 0; j < 8; ++j) { const int k = i - j; if (k >= 0 && k <= 30) acc[j] += wk[k] * xv; } }
#pragma unroll
            for (int j = 0; j < 8; ++j) *(LAS f32x2*)(CT + (8 * ch + j) * 1024 + c) = acc[j];
#pragma unroll
            for (int i = 0; i < 30; ++i) X[i] = X[i + 8];
#pragma unroll
            for (int j = 0; j < 8; ++j) X[30 + j] = NX[j];
        }
        __syncthreads();
#pragma unroll 1
        for (int tt = 0; tt < 4; ++tt) { const int tok = 4 * wave + tt; const size_t m = (size_t)b * SEQ + t0 + tok;
            f32x4 v[4]; float s = 0.f;
#pragma unroll
            for (int j = 0; j < 4; ++j) { v[j] = *(const LAS f32x4*)(CT + tok * 1024 + 4 * lane + 256 * j); s += (v[j].x + v[j].y) + (v[j].z + v[j].w); }
            const float mean = wave_sum(s) * (1.0f / 1024.0f); float s2 = 0.f;
#pragma unroll
            for (int j = 0; j < 4; ++j) { v[j] = v[j] - mean; s2 += (v[j].x * v[j].x + v[j].y * v[j].y) + (v[j].z * v[j].z + v[j].w * v[j].w); }
            const float rstd = rsqrtf(wave_sum(s2) * (1.0f / 1024.0f) + LN_EPS);
#pragma unroll
            for (int j = 0; j < 4; ++j) { const f32x4 g = *(const f32x4*)(a.in(16) + 4 * lane + 256 * j), bt = *(const f32x4*)(a.in(17) + 4 * lane + 256 * j);
                f32x4 y = v[j] * rstd * g + bt;
#pragma unroll
                for (int e = 0; e < 4; ++e) y[e] = y[e] * fsigmoid(y[e]);
                u32x2 w; w.x = pk2(y[0], y[1]); w.y = pk2(y[2], y[3]); *(u32x2*)(CV + m * 1024 + 4 * lane + 256 * j) = w; }
        }
        __syncthreads();
    }
}

#define XB_TMO      128
#define XB_XCNT(j)  (256  + 64 * (j))
#define XB_XSUB(j)  (1280 + 64 * (j))
#define XB_XGEN(j)  (2304 + 64 * (j))
#define XB_TOP      3328
#define XB_TOPGEN   3392
#define XCD_BAR_WORDS 3456
#define XB_SPIN_CAP (1u << 18)

__device__ __forceinline__ unsigned xb_ld(unsigned* p)              { return __hip_atomic_load(p, __ATOMIC_RELAXED, __HIP_MEMORY_SCOPE_AGENT); }
__device__ __forceinline__ unsigned xb_add(unsigned* p, unsigned v) { return __hip_atomic_fetch_add(p, v, __ATOMIC_RELAXED, __HIP_MEMORY_SCOPE_AGENT); }
__device__ __forceinline__ unsigned xb_xcc_id() { return (unsigned)__builtin_amdgcn_s_getreg((3 << 11) | 20) & 0xFu; }
#define XB_SPIN(cond, bar) do { unsigned _sp = 0; while (cond) { __builtin_amdgcn_s_sleep(1); \
    if ((++_sp & 255u) == 0u) { if (xb_ld(&(bar)[XB_TMO])) break; if (_sp > XB_SPIN_CAP) { atomicAdd(&(bar)[XB_TMO], 1u); break; } } } } while (0)

struct XcdBarrier {
    unsigned* bar; unsigned x;
    volatile LAS unsigned* st;
};

__device__ __forceinline__ XcdBarrier xcd_barrier_post(unsigned* bar, volatile LAS unsigned* st) {
    XcdBarrier b; b.bar = bar; b.x = xb_xcc_id(); b.st = st;
    if (threadIdx.x == 0) (void)xb_add(&bar[XB_XCNT(b.x)], 1u);
    return b;
}
__device__ __forceinline__ void xcd_barrier_complete(unsigned* bar, unsigned x, unsigned& nloc, unsigned& nx) {
    const unsigned G = gridDim.x * gridDim.y * gridDim.z;
    unsigned sum, cnt, mine, sp = 0u;
    for (;;) {
        sum = 0u; cnt = 0u; mine = 0u;
#pragma unroll
        for (unsigned j = 0; j < 16; ++j) { const unsigned c = xb_ld(&bar[XB_XCNT(j)]); sum += c; cnt += (c > 0u) ? 1u : 0u; mine = (j == x) ? c : mine; }
        if (sum == G) break;
        __builtin_amdgcn_s_sleep(1);
        if ((++sp & 255u) == 0u) { if (xb_ld(&bar[XB_TMO])) break; if (sp > XB_SPIN_CAP) { atomicAdd(&bar[XB_TMO], 1u); break; } }
    }
    nloc = mine > 0u ? mine : 1u; nx = cnt > 0u ? cnt : 1u;
}

__device__ __forceinline__ void xcd_barrier(const XcdBarrier& b) {
    asm volatile("s_waitcnt vmcnt(0)" ::: "memory");
    __syncthreads();
    if (threadIdx.x == 0) {
        unsigned* bar = b.bar; asm volatile("" : "+s"(bar));
        __builtin_amdgcn_s_waitcnt(0);
        unsigned nloc = b.st[0], nx = b.st[1];
        if (nloc == 0u) { xcd_barrier_complete(bar, b.x, nloc, nx); b.st[0] = nloc; b.st[1] = nx; }
        const unsigned old = xb_add(&bar[XB_XSUB(b.x)], 1u);
        const unsigned gen = old / nloc;
        if (old + 1u == (gen + 1u) * nloc) {
            __builtin_amdgcn_fence(__ATOMIC_RELEASE, "agent");
            asm volatile("s_waitcnt vmcnt(0)" ::: "memory");
            const unsigned og = xb_add(&bar[XB_TOP], 1u);
            const unsigned tg = og / nx;
            if (og + 1u == (tg + 1u) * nx) xb_add(&bar[XB_TOPGEN], 1u);
            else XB_SPIN(xb_ld(&bar[XB_TOPGEN]) == tg, bar);
            __builtin_amdgcn_fence(__ATOMIC_ACQUIRE, "agent");
            xb_add(&bar[XB_XGEN(b.x)], 1u);
            asm volatile("s_waitcnt vmcnt(0)" ::: "memory");
        } else {
            XB_SPIN(xb_ld(&bar[XB_XGEN(b.x)]) == gen, bar);
            __builtin_amdgcn_fence(__ATOMIC_ACQUIRE, "agent");
            asm volatile("s_waitcnt vmcnt(0)" ::: "memory");
        }
    }
    __syncthreads();
}

__global__ void __launch_bounds__(NWAVES * 64, 2) trunk_fwd(Args kargs) {
    extern __shared__ __attribute__((aligned(16))) unsigned char lds_raw[];
    cg::grid_group grid = cg::this_grid();
    LAS unsigned char* lds = (LAS unsigned char*)lds_raw;
    const int wave = __builtin_amdgcn_readfirstlane((int)threadIdx.x >> 6); int lane = 0;
    const int G = gridDim.x, gw = blockIdx.x * NWAVES + wave, NGW = G * NWAVES;
    LAS unsigned char* wlds = lds + wave * 16384;
    volatile LAS unsigned* MISC = (volatile LAS unsigned*)(lds + MISC_OFF);
    if (threadIdx.x < 32) MISC[threadIdx.x] = 0u;
    __syncthreads();
    XcdBarrier bar = xcd_barrier_post((unsigned*)(argview().ws() + WS_BAR), MISC + 8);
#define GRID_BAR() xcd_barrier(bar)

    for (int rep = 0; rep < PROBE_P; ++rep) prologue(argview(), lds, wave, lane);
    grid.sync();
#pragma unroll 1
    for (int L = 0; L < 2; ++L) {
        if (L == 0) {
            { const ArgView a = argview(); unsigned char* ws = a.ws();
              pg8::Gemm g{(const bf16_t*)(ws + WS_XB), (const bf16_t*)(ws + WS_WIN), M, NPROJ, D}; pg8::StaticOrder S; S.init(M, NPROJ, LG(), LB());
              pg8::EpiScale<0> E{(bf16_t*)(ws + WS_PROJ), NPROJ, (const float*)(ws + WS_SS)};
              pg8::gemm_phase<pg8::EpiScale<0>, pg8::StaticOrder, true, true>(lds, g, S, E, wave); }
            GRID_BAR();
            for (int rep = 0; rep < PROBE_X; ++rep) { const int gwl = LB() * NWAVES + wave, ngw = LG() * NWAVES;
              for (int it = gwl; it < 2048; it += ngw) lru_item<1>(argview(), wlds, it, lane);
              for (int it = gwl; it < 4096; it += ngw) attn_item(argview(), wlds, it, lane); }
            GRID_BAR();
            for (int rep = 0; rep < PROBE_X; ++rep) { const int gwl = LB() * NWAVES + wave, ngw = LG() * NWAVES;
              for (int it = gwl; it < 2048; it += ngw) lru_item<2>(argview(), wlds, it, lane);
              for (int it = 4096 + gwl; it < 8192; it += ngw) attn_item(argview(), wlds, it, lane); }
            GRID_BAR();
        } else {
            { const ArgView a = argview(); unsigned char* ws = a.ws();
              pg8::Gemm g{(const bf16_t*)(ws + WS_XB), (const bf16_t*)(ws + WS_PW1), M, 2048, D}; pg8::StaticOrder S; S.init(M, 2048, LG(), LB());
              pg8::EpiGlu E{(bf16_t*)(ws + WS_GL), (const float*)(ws + WS_SS) + 2 * M, a.in(13)};
              pg8::gemm_phase<pg8::EpiGlu, pg8::StaticOrder, true, true>(lds, g, S, E, wave); }
            GRID_BAR();
            for (int rep = 0; rep < PROBE_C; ++rep) conv_phase(argview(), lds, wave, lane);
            GRID_BAR();
        }
        { const ArgView a = argview(); unsigned char* ws = a.ws();
          pg8::Gemm g{(const bf16_t*)(ws + (L == 0 ? WS_YMIX : WS_CV)), (const bf16_t*)(ws + (L == 0 ? WS_WOUT : WS_PW2)), M, D, D}; pg8::StaticOrder S; S.init(M, D, LG(), LB());
          pg8::EpiResid E{L == 0 ? a.in(0) : nullptr, (const bf16_t*)(ws + WS_XB), nullptr, (bf16_t*)(ws + WS_XB), L == 0 ? nullptr : a.in(19), (float*)(ws + WS_SS) + (2 * L + 1) * M};
          pg8::gemm_phase<pg8::EpiResid, pg8::StaticOrder, true, true>(lds, g, S, E, wave); }
        GRID_BAR();
        { const ArgView a = argview(); unsigned char* ws = a.ws();
          pg8::Gemm g{(const bf16_t*)(ws + WS_XB), (const bf16_t*)(ws + (L == 0 ? WS_W1A : WS_W1B)), M, FF, D}; pg8::StaticOrder S; S.init(M, FF, LG(), LB());
          pg8::EpiScale<1> E{(bf16_t*)(ws + WS_H), FF, (const float*)(ws + WS_SS) + (2 * L + 1) * M};
          pg8::gemm_phase<pg8::EpiScale<1>, pg8::StaticOrder, true, true>(lds, g, S, E, wave); }
        GRID_BAR();
        { const ArgView a = argview(); unsigned char* ws = a.ws();
          pg8::Gemm g{(const bf16_t*)(ws + WS_H), (const bf16_t*)(ws + (L == 0 ? WS_W2A : WS_W2B)), M, D, FF}; pg8::StaticOrder S; S.init(M, D, LG(), LB());
          pg8::EpiResid E{nullptr, (const bf16_t*)(ws + WS_XB), L == 0 ? nullptr : a.out(), (bf16_t*)(ws + WS_XB), nullptr, (float*)(ws + WS_SS) + (2 * L + 2) * M};
          pg8::gemm_phase<pg8::EpiResid, pg8::StaticOrder, true, true>(lds, g, S, E, wave); }
        GRID_BAR();
    }
    { const ArgView a = argview(); const float* SS = (const float*)(a.ws() + WS_SS); float* out = a.out(); const float* fg = a.in(23);
      lane = (int)__builtin_amdgcn_mbcnt_hi(~0u, __builtin_amdgcn_mbcnt_lo(~0u, 0u));
      f32x4 gv[4];
#pragma unroll
      for (int j = 0; j < 4; ++j) gv[j] = ((const f32x4*)fg + lane)[64 * j];
      for (int m0 = 4 * gw; m0 < M; m0 += 4 * NGW) {
        f32x4 v[4][4]; float rs[4];
#pragma unroll
        for (int r = 0; r < 4; ++r) { rs[r] = rsqrtf(SS[4 * M + m0 + r] * (1.0f / 1024.0f) + RMS_EPS);
#pragma unroll
            for (int j = 0; j < 4; ++j) v[r][j] = ((const f32x4*)(out + (size_t)(m0 + r) * D) + lane)[64 * j]; }
#pragma unroll
        for (int r = 0; r < 4; ++r)
#pragma unroll
            for (int j = 0; j < 4; ++j) ((f32x4*)(out + (size_t)(m0 + r) * D) + lane)[64 * j] = v[r][j] * rs[r] * gv[j];
      } }
}

extern "C" void kernel_launch(void* const* d_in, const int* in_sizes, int n_in, void* d_out, int out_size, void* d_ws, size_t ws_size, hipStream_t stream) {
    static int grid = 0;
    if (grid == 0) {
        if (n_in != 24 || in_sizes[0] != M * D || out_size != M * D || ws_size < WS_END) { fprintf(stderr, "kernel_launch: unexpected shapes (n_in %d, ws %zu)\n", n_in, ws_size); grid = -1; return; }
        int dev = 0, cus = 0, per_cu = 0;
        hipGetDevice(&dev); hipDeviceGetAttribute(&cus, hipDeviceAttributeMultiprocessorCount, dev);
        hipFuncSetAttribute((const void*)trunk_fwd, hipFuncAttributeMaxDynamicSharedMemorySize, LDS_BYTES);
        hipOccupancyMaxActiveBlocksPerMultiprocessor(&per_cu, (const void*)trunk_fwd, NWAVES * 64, LDS_BYTES);
        if (per_cu < 1) per_cu = 1;
        (void)hipGetLastError();
        grid = cus * per_cu;
    }
    if (grid < 0) return;
    if (hipMemsetAsync((char*)d_ws + WS_BAR, 0, 16384, stream) != hipSuccess) { fprintf(stderr, "memset failed\n"); return; }
    Args a{};
    for (int i = 0; i < 24; ++i) a.in[i] = (const float*)d_in[i];
    a.out = (float*)d_out; a.ws = (unsigned char*)d_ws;
    void* args[] = {&a};
    hipError_t e = hipLaunchCooperativeKernel((const void*)trunk_fwd, dim3(grid), dim3(NWAVES * 64), args, LDS_BYTES, stream);
    if (e != hipSuccess) fprintf(stderr, "cooperative launch failed: %s (grid %d)\n", hipGetErrorString(e), grid);
}
```

```cpp
#include <hip/hip_runtime.h>
#include <hip/hip_cooperative_groups.h>
#include <cstdio>
#include <cstdint>
namespace cg = cooperative_groups;
namespace pg8 {
#define PG8_LAS __attribute__((address_space(3)))
typedef unsigned short bf16_t;
typedef short bf16x8 __attribute__((ext_vector_type(8)));
typedef float f32x4 __attribute__((ext_vector_type(4)));
typedef unsigned u32x4 __attribute__((ext_vector_type(4)));
constexpr int BM = 256, BK = 64, HALF = 128, HTB = HALF * BK * 2  , STAGE_BYTES = 8 * HTB, NXCD = 8, WGM = 8;

__host__ __device__ __forceinline__ int lds_byte(int r, int c) { const int st = (r >> 4) * 2 + (c >> 5), rr = r & 15, cc = c & 31, ob = rr * 64 + cc * 2; return st * 1024 + (ob ^ (((ob >> 9) & 1) << 5)); }
__host__ __device__ __forceinline__ void stage_rc(int b, int& R, int& C) { const int st = b / 1024, sb = b % 1024, swz = sb ^ (((sb >> 9) & 1) << 5); R = (st >> 1) * 16 + swz / 64; C = (st & 1) * 32 + (swz % 64) / 2; }
__host__ __device__ __forceinline__ int perm32(int rho) { const int n = rho >> 4, i = rho & 15; return 8 * (i >> 2) + 4 * n + (i & 3); }

struct Unit { int pm, pn; };
struct Gemm { const bf16_t* A; const bf16_t* Bt; int M, N, K; };

struct StaticOrder {
    int nM, nN, nwg, G, c;
    __host__ __device__ void init(int M, int N, int G_, int c_) { nM = M / BM; nN = N / BM; nwg = nM * nN; G = G_; c = c_; }
    __host__ __device__ bool next(int i, Unit& u) const {
        const long L = (long)i * G + c; if (L >= nwg) return false;
        int wgid = (int)L; { const int q = nwg / NXCD, r = nwg % NXCD, xcd = wgid % NXCD, off = wgid / NXCD; wgid = (xcd < r ? xcd * (q + 1) : r * (q + 1) + (xcd - r) * q) + off; }
        const int nig = WGM * nN, gid = wgid / nig, fm = gid * WGM, gsz = (nM - fm) < WGM ? (nM - fm) : WGM;
        u.pm = fm + ((wgid % nig) % gsz); u.pn = (wgid % nig) / gsz; return true;
    }
    __device__ __forceinline__ void a_ready(const Unit&) const {}
    __device__ __forceinline__ void done(const Unit&) const {}
};

__device__ __forceinline__ unsigned cvt_pk_bf16(float lo, float hi) { unsigned r; asm volatile("v_cvt_pk_bf16_f32 %0, %1, %2" : "=v"(r) : "v"(lo), "v"(hi)); return r; }
__device__ __forceinline__ float fast_exp(float x) { return __builtin_amdgcn_exp2f(x * 1.4426950408889634f); }
__device__ __forceinline__ float fast_sigmoid(float x) { return __builtin_amdgcn_rcpf(1.f + fast_exp(-x)); }
constexpr float RMS_EPS_ = 1e-6f;
template <int ACT> struct EpiScale {
    static constexpr bool PERM = true, AFTER_DRAIN = false;
    bf16_t* O; int ldc; const float* ss;
    __device__ __forceinline__ void operator()(const f32x4 (&acc)[2][2][4][2], const Unit& u, int wr, int wc, int fr, int fq) const {
        const int row0 = u.pm * BM + wr * 64 + fr, col0 = u.pn * BM + wc * 32 + 8 * fq;
#pragma unroll
        for (int ai = 0; ai < 2; ++ai)
#pragma unroll
            for (int m = 0; m < 4; ++m) { const int row = row0 + ai * HALF + m * 16; const float rs = rsqrtf(ss[row] * (1.0f / 1024.0f) + RMS_EPS_);
                bf16_t* rowp = O + (size_t)row * ldc + col0;
#pragma unroll
                for (int bj = 0; bj < 2; ++bj) { f32x4 v0 = acc[ai][bj][m][0] * rs, v1 = acc[ai][bj][m][1] * rs;
                    if (ACT == 1) {
#pragma unroll
                        for (int e = 0; e < 4; ++e) { const float a0 = fmaxf(v0[e], 0.f), a1 = fmaxf(v1[e], 0.f); v0[e] = a0 * a0; v1[e] = a1 * a1; } }
                    u32x4 w; w.x = cvt_pk_bf16(v0[0], v0[1]); w.y = cvt_pk_bf16(v0[2], v0[3]); w.z = cvt_pk_bf16(v1[0], v1[1]); w.w = cvt_pk_bf16(v1[2], v1[3]);
                    *(u32x4*)(rowp + bj * HALF) = w; } }
    }
};
struct EpiGlu {
    static constexpr bool PERM = true, AFTER_DRAIN = false;
    bf16_t* O; const float* ss; const float* bias;
    __device__ __forceinline__ void operator()(const f32x4 (&acc)[2][2][4][2], const Unit& u, int wr, int wc, int fr, int fq) const {
        const int row0 = u.pm * BM + wr * 64 + fr, ch0 = u.pn * HALF + wc * 32 + 8 * fq;
        f32x4 bv[2], bg[2];
#pragma unroll
        for (int n = 0; n < 2; ++n) { bv[n] = *(const f32x4*)(bias + ch0 + 4 * n); bg[n] = *(const f32x4*)(bias + 1024 + ch0 + 4 * n); }
#pragma unroll
        for (int ai = 0; ai < 2; ++ai)
#pragma unroll
            for (int m = 0; m < 4; ++m) { const int row = row0 + ai * HALF + m * 16; const float rs = rsqrtf(ss[row] * (1.0f / 1024.0f) + RMS_EPS_);
                f32x4 o[2];
#pragma unroll
                for (int n = 0; n < 2; ++n) { const f32x4 v = acc[ai][0][m][n] * rs + bv[n], g = acc[ai][1][m][n] * rs + bg[n];
#pragma unroll
                    for (int e = 0; e < 4; ++e) o[n][e] = v[e] * fast_sigmoid(g[e]); }
                u32x4 w; w.x = cvt_pk_bf16(o[0][0], o[0][1]); w.y = cvt_pk_bf16(o[0][2], o[0][3]); w.z = cvt_pk_bf16(o[1][0], o[1][1]); w.w = cvt_pk_bf16(o[1][2], o[1][3]);
                *(u32x4*)(O + (size_t)row * 1024 + ch0) = w; }
    }
};
struct EpiResid {
    static constexpr bool PERM = true, AFTER_DRAIN = false;
    const float* baseF; const bf16_t* baseB; float* outF; bf16_t* outB; const float* bias; float* ssout;
    __device__ __forceinline__ void operator()(const f32x4 (&acc)[2][2][4][2], const Unit& u, int wr, int wc, int fr, int fq) const {
        const int row0 = u.pm * BM + wr * 64 + fr, col0 = u.pn * BM + wc * 32 + 8 * fq;
        f32x4 bv[2][2];
#pragma unroll
        for (int bj = 0; bj < 2; ++bj)
#pragma unroll
            for (int n = 0; n < 2; ++n) bv[bj][n] = bias ? *(const f32x4*)(bias + col0 + bj * HALF + 4 * n) : (f32x4){0.f, 0.f, 0.f, 0.f};
#pragma unroll
        for (int ai = 0; ai < 2; ++ai)
#pragma unroll
            for (int m = 0; m < 4; ++m) { const int row = row0 + ai * HALF + m * 16; const size_t off = (size_t)row * 1024 + col0; float s = 0.f;
#pragma unroll
                for (int bj = 0; bj < 2; ++bj) {
                    f32x4 b0, b1;
                    if (baseF) { b0 = *(const f32x4*)(baseF + off + bj * HALF); b1 = *(const f32x4*)(baseF + off + bj * HALF + 4); }
                    else { const u32x4 r = *(const u32x4*)(baseB + off + bj * HALF);
                        b0 = (f32x4){__uint_as_float(r.x << 16), __uint_as_float(r.x & 0xffff0000u), __uint_as_float(r.y << 16), __uint_as_float(r.y & 0xffff0000u)};
                        b1 = (f32x4){__uint_as_float(r.z << 16), __uint_as_float(r.z & 0xffff0000u), __uint_as_float(r.w << 16), __uint_as_float(r.w & 0xffff0000u)}; }
                    const f32x4 v0 = acc[ai][bj][m][0] + bv[bj][0] + b0, v1 = acc[ai][bj][m][1] + bv[bj][1] + b1;
                    if (outF) { *(f32x4*)(outF + off + bj * HALF) = v0; *(f32x4*)(outF + off + bj * HALF + 4) = v1; }
                    else { u32x4 w; w.x = cvt_pk_bf16(v0[0], v0[1]); w.y = cvt_pk_bf16(v0[2], v0[3]); w.z = cvt_pk_bf16(v1[0], v1[1]); w.w = cvt_pk_bf16(v1[2], v1[3]);
                        *(u32x4*)(outB + off + bj * HALF) = w; }
                    s += (v0[0] * v0[0] + v0[1] * v0[1]) + (v0[2] * v0[2] + v0[3] * v0[3]) + (v1[0] * v1[0] + v1[1] * v1[1]) + (v1[2] * v1[2] + v1[3] * v1[3]); }
                s += __shfl_xor(s, 16); s += __shfl_xor(s, 32);
                if (fq == 0) unsafeAtomicAdd(ssout + row, s);
                asm volatile("" ::: "memory"); }
    }
};
template <class Epi, class Sched, bool ALIGN_EPI = false, bool SP2 = false>
__device__ __forceinline__ void gemm_phase(PG8_LAS unsigned char* lds, const Gemm g, const Sched& S, const Epi& E, const int wid_in) {
    int lane_l = (int)__builtin_amdgcn_mbcnt_hi(~0u, __builtin_amdgcn_mbcnt_lo(~0u, 0u)); asm volatile("" : "+v"(lane_l));
    int wid_l = wid_in; asm volatile("" : "+s"(wid_l));
    const int wid = wid_l, lane = lane_l, tid = wid * 64 + lane, wr = wid >> 2, wc = wid & 3, fr = lane & 15, fq = lane >> 4;
    const int K = g.K, nt = K / BK;
    unsigned voffA[2], voffB[2];
#pragma unroll
    for (int i = 0; i < 2; ++i) { int R, C; stage_rc(tid * 16 + i * 8192, R, C); const int Rb = Epi::PERM ? ((R & ~31) + perm32(R & 31)) : R;
        voffA[i] = (unsigned)(R * K + C) * 2u; voffB[i] = (unsigned)(Rb * K + C) * 2u; }
    const size_t kstep = (size_t)(BK * 2);
    const size_t hstep = (size_t)HALF * K * 2;
    const size_t tstep = 2 * hstep;
    const unsigned ldsw = (unsigned)wid * 1024u;
    const int aoff = lds_byte(wr * 64 + fr, fq * 8), boff = lds_byte(wc * 32 + fr, fq * 8);
#define PG8_SA(b, h) (((b) * 2 + (h)) * HTB)
#define PG8_SB(b, h) ((4 + (b) * 2 + (h)) * HTB)
#define PG8_STAGE(bufoff, gbase, voff) do { _Pragma("unroll") for (int _i = 0; _i < 2; ++_i) \
        __builtin_amdgcn_global_load_lds((const unsigned*)((const char*)(gbase) + (voff)[_i]), (PG8_LAS unsigned*)(lds + (bufoff) + ldsw + _i * 8192), 16, 0, 0); } while (0)
#define PG8_LDA(dst, b, h) do { _Pragma("unroll") for (int m = 0; m < 4; ++m) _Pragma("unroll") for (int k = 0; k < 2; ++k) dst[m][k] = *(const PG8_LAS bf16x8*)(lds + PG8_SA(b, h) + aoff + m * 2048 + k * 1024); } while (0)
#define PG8_LDB(dst, b, h) do { _Pragma("unroll") for (int n = 0; n < 2; ++n) _Pragma("unroll") for (int k = 0; k < 2; ++k) dst[n][k] = *(const PG8_LAS bf16x8*)(lds + PG8_SB(b, h) + boff + n * 2048 + k * 1024); } while (0)
#define PG8_MMA(ai, bj, At, Bt) do { __builtin_amdgcn_s_setprio(1); _Pragma("unroll") for (int m = 0; m < 4; ++m) _Pragma("unroll") for (int n = 0; n < 2; ++n) _Pragma("unroll") for (int k = 0; k < 2; ++k) \
        acc[ai][bj][m][n] = __builtin_amdgcn_mfma_f32_16x16x32_bf16(Bt[n][k], At[m][k], acc[ai][bj][m][n], 0, 0, 0); __builtin_amdgcn_s_setprio(0); } while (0)
#define PG8_WAIT_V(n) asm volatile("s_waitcnt vmcnt(" #n ")" ::: "memory")
#define PG8_WAIT_L(n) asm volatile("s_waitcnt lgkmcnt(" #n ")" ::: "memory")
#define PG8_BAR __builtin_amdgcn_s_barrier()
#define PG8_SCHED __builtin_amdgcn_sched_barrier(0)
    Unit cur, nxt; int ui = 0;
    if (!S.next(0, cur)) return;
    f32x4 acc[2][2][4][2];
#pragma unroll
    for (int a = 0; a < 2; ++a)
#pragma unroll
        for (int b = 0; b < 2; ++b)
#pragma unroll
            for (int m = 0; m < 4; ++m)
#pragma unroll
                for (int n = 0; n < 2; ++n) acc[a][b][m][n] = (f32x4){0.f, 0.f, 0.f, 0.f};
    bf16x8 At[4][2], B0[2][2], B1[2][2];
    const char* cA = (const char*)g.A + (size_t)cur.pm * tstep; const char* cB = (const char*)g.Bt + (size_t)cur.pn * tstep;
    S.a_ready(cur);
    if constexpr (SP2) {
        PG8_STAGE(PG8_SB(0, 0), cB, voffB); PG8_STAGE(PG8_SB(0, 1), cB + hstep, voffB); PG8_STAGE(PG8_SA(0, 0), cA, voffA); PG8_STAGE(PG8_SA(0, 1), cA + hstep, voffA);
        if (wr == 1) PG8_BAR;
        PG8_WAIT_V(2); PG8_BAR;
        PG8_STAGE(PG8_SB(1, 0), cB + kstep, voffB); PG8_STAGE(PG8_SA(1, 0), cA + kstep, voffA); PG8_STAGE(PG8_SB(1, 1), cB + hstep + kstep, voffB);
        PG8_WAIT_V(6); PG8_BAR;
    } else {
        PG8_STAGE(PG8_SB(0, 0), cB, voffB); PG8_STAGE(PG8_SA(0, 0), cA, voffA); PG8_STAGE(PG8_SB(0, 1), cB + hstep, voffB); PG8_STAGE(PG8_SA(0, 1), cA + hstep, voffA);
        if (wr == 1) PG8_BAR;
        PG8_WAIT_V(4); PG8_BAR;
        PG8_STAGE(PG8_SB(1, 0), cB + kstep, voffB); PG8_STAGE(PG8_SA(1, 0), cA + kstep, voffA); PG8_STAGE(PG8_SB(1, 1), cB + hstep + kstep, voffB);
        PG8_WAIT_V(6); PG8_BAR;
    }
    for (;;) {
        const bool has_next = S.next(ui + 1, nxt);
        const char* nA = has_next ? (const char*)g.A + (size_t)nxt.pm * tstep : cA; const char* nB = has_next ? (const char*)g.Bt + (size_t)nxt.pn * tstep : cB;
        for (int t = 0; t < nt; t += 2) {
            const bool last = (t == nt - 2);
            const char* a1 = cA + (size_t)(t + 1) * kstep;
            const char* a2 = last ? nA : cA + (size_t)(t + 2) * kstep; const char* b2 = last ? nB : cB + (size_t)(t + 2) * kstep;
            const char* a3 = a2 + kstep; const char* b3 = b2 + kstep;
            if (last && has_next) S.a_ready(nxt);
            if constexpr (SP2) {
            PG8_LDB(B0, 0, 0); PG8_LDB(B1, 0, 1); PG8_SCHED; PG8_LDA(At, 0, 0); PG8_STAGE(PG8_SA(1, 1), a1 + hstep, voffA);
            PG8_WAIT_V(8); PG8_WAIT_L(0); PG8_BAR; PG8_MMA(0, 0, At, B0); PG8_MMA(0, 1, At, B1); PG8_BAR; PG8_SCHED;
            PG8_LDA(At, 0, 1); PG8_STAGE(PG8_SB(0, 0), b2, voffB); PG8_STAGE(PG8_SB(0, 1), b2 + hstep, voffB); PG8_STAGE(PG8_SA(0, 0), a2, voffA);
            PG8_WAIT_V(8); PG8_WAIT_L(0); PG8_BAR; PG8_MMA(1, 0, At, B0); PG8_MMA(1, 1, At, B1); PG8_BAR; PG8_SCHED;
            PG8_LDB(B0, 1, 0); PG8_LDB(B1, 1, 1); PG8_SCHED; PG8_LDA(At, 1, 0); PG8_STAGE(PG8_SA(0, 1), a2 + hstep, voffA);
            PG8_WAIT_V(8); PG8_WAIT_L(0); PG8_BAR; PG8_MMA(0, 0, At, B0); PG8_MMA(0, 1, At, B1); PG8_BAR; PG8_SCHED;
            PG8_LDA(At, 1, 1); PG8_STAGE(PG8_SB(1, 0), b3, voffB); PG8_STAGE(PG8_SB(1, 1), b3 + hstep, voffB); PG8_STAGE(PG8_SA(1, 0), a3, voffA);
            PG8_WAIT_V(8); PG8_WAIT_L(0); PG8_BAR; PG8_MMA(1, 0, At, B0); PG8_MMA(1, 1, At, B1); PG8_BAR; PG8_SCHED;
            } else {
            PG8_LDB(B0, 0, 0); PG8_SCHED; PG8_LDA(At, 0, 0); PG8_STAGE(PG8_SA(1, 1), a1 + hstep, voffA);
            PG8_WAIT_L(8); PG8_BAR; PG8_WAIT_L(0); PG8_MMA(0, 0, At, B0); PG8_BAR; PG8_SCHED;
            PG8_LDB(B1, 0, 1); PG8_STAGE(PG8_SB(0, 0), b2, voffB);
            PG8_BAR; PG8_WAIT_L(0); PG8_MMA(0, 1, At, B1); PG8_BAR;
            PG8_LDA(At, 0, 1); PG8_STAGE(PG8_SA(0, 0), a2, voffA);
            PG8_BAR; PG8_WAIT_L(0); PG8_MMA(1, 0, At, B0); PG8_BAR; PG8_SCHED;
            PG8_STAGE(PG8_SB(0, 1), b2 + hstep, voffB);
            PG8_WAIT_V(6); PG8_BAR; PG8_MMA(1, 1, At, B1); PG8_BAR;
            PG8_LDB(B0, 1, 0); PG8_SCHED; PG8_LDA(At, 1, 0); PG8_STAGE(PG8_SA(0, 1), a2 + hstep, voffA);
            PG8_WAIT_L(8); PG8_BAR; PG8_WAIT_L(0); PG8_MMA(0, 0, At, B0); PG8_BAR; PG8_SCHED;
            PG8_LDB(B1, 1, 1); PG8_STAGE(PG8_SB(1, 0), b3, voffB);
            PG8_BAR; PG8_WAIT_L(0); PG8_MMA(0, 1, At, B1); PG8_BAR;
            PG8_LDA(At, 1, 1); PG8_STAGE(PG8_SA(1, 0), a3, voffA);
            PG8_BAR; PG8_WAIT_L(0); PG8_MMA(1, 0, At, B0); PG8_BAR; PG8_SCHED;
            PG8_STAGE(PG8_SB(1, 1), b3 + hstep, voffB);
            PG8_WAIT_V(6); PG8_BAR; PG8_MMA(1, 1, At, B1); PG8_BAR;
            }
        }
        if constexpr (ALIGN_EPI) { if (wr == 0) PG8_BAR; }
        if constexpr (!Epi::AFTER_DRAIN) { E(acc, cur, wr, wc, fr, fq); S.done(cur); }
        if (!has_next) break;
#pragma unroll
        for (int a = 0; a < 2; ++a)
#pragma unroll
            for (int b = 0; b < 2; ++b)
#pragma unroll
                for (int m = 0; m < 4; ++m)
#pragma unroll
                    for (int n = 0; n < 2; ++n) acc[a][b][m][n] = (f32x4){0.f, 0.f, 0.f, 0.f};
        cur = nxt; cA = nA; cB = nB; ++ui;
        if constexpr (ALIGN_EPI) { if (wr == 1) PG8_BAR; }
    }
    PG8_WAIT_V(0);
    if constexpr (!ALIGN_EPI) { if (wr == 0) PG8_BAR; }
    PG8_BAR;
    if constexpr (Epi::AFTER_DRAIN) { E.fused(acc, cur, wr, wc, fr, fq, lds, wid, lane); S.done(cur); }
#undef PG8_SA
#undef PG8_SB
#undef PG8_STAGE
#undef PG8_LDA
#undef PG8_LDB
#undef PG8_MMA
#undef PG8_WAIT_V
#undef PG8_WAIT_L
#undef PG8_BAR
#undef PG8_SCHED
}
}
using pg8::bf16_t; using pg8::bf16x8; using pg8::f32x4; using pg8::u32x4;
typedef float f32x16 __attribute__((ext_vector_type(16)));
typedef float f32x2 __attribute__((ext_vector_type(2)));
typedef unsigned u32x2 __attribute__((ext_vector_type(2)));
#define LAS __attribute__((address_space(3)))
constexpr int NWAVES = 8;
#define PROBE_P 1
#define PROBE_X 1
#define PROBE_C 1
constexpr int BATCH = 8, SEQ = 4096, D = 1024, M = BATCH * SEQ, FF = 4096, NPROJ = 2560;
constexpr float RMS_EPS = 1e-6f, LN_EPS = 1e-5f;
constexpr float LOG2E = 1.4426950408889634f, LN2 = 0.6931471805599453f;
constexpr size_t MiB = 1u << 20;
constexpr size_t WS_SS = 0;
constexpr size_t WS_BAR = 768 * 1024;
constexpr size_t WS_SUM = 1 * MiB;
constexpr size_t WS_WIN = 2 * MiB, WS_WOUT = 7 * MiB, WS_W1A = 9 * MiB, WS_W2A = 17 * MiB, WS_PW1 = 25 * MiB, WS_PW2 = 29 * MiB, WS_W1B = 31 * MiB, WS_W2B = 39 * MiB;
constexpr size_t WS_GA = 47 * MiB, WS_GX = 47 * MiB + 65536;
constexpr size_t WS_XB = 64 * MiB;
constexpr size_t WS_PROJ = 128 * MiB;
constexpr size_t WS_YMIX = 288 * MiB;
constexpr size_t WS_H = 128 * MiB;
constexpr size_t WS_GL = 128 * MiB;
constexpr size_t WS_CV = 192 * MiB;
constexpr size_t WS_END = 384 * MiB;
constexpr int MISC_OFF = 131072 + 320;
constexpr int LDS_BYTES = 147456;

#define LDS_WAIT() asm volatile("s_waitcnt lgkmcnt(0)" ::: "memory")
__device__ __forceinline__ float fexp2(float x) { return __builtin_amdgcn_exp2f(x); }
__device__ __forceinline__ float flog2(float x) { return __builtin_amdgcn_logf(x); }
__device__ __forceinline__ float fexp(float x) { return fexp2(x * LOG2E); }
__device__ __forceinline__ float fsigmoid(float x) { return __builtin_amdgcn_rcpf(1.f + fexp(-x)); }
__device__ __forceinline__ unsigned pk2(float lo, float hi) { return pg8::cvt_pk_bf16(lo, hi); }
__device__ __forceinline__ float bf_lo(unsigned u) { return __uint_as_float(u << 16); }
__device__ __forceinline__ float bf_hi(unsigned u) { return __uint_as_float(u & 0xffff0000u); }
__device__ __forceinline__ float bf1(bf16_t u) { return __uint_as_float((unsigned)u << 16); }
__device__ __forceinline__ int crow(int r, int hi) { return (r & 3) + 8 * (r >> 2) + 4 * hi; }
__device__ __forceinline__ float wave_sum(float v) {
#pragma unroll
    for (int o = 1; o < 64; o <<= 1) v += __shfl_xor(v, o);
    return v;
}

struct Args { const float* in[24]; float* out; unsigned char* ws; };
__device__ __forceinline__ int LB() { int b = (int)blockIdx.x; asm volatile("" : "+s"(b)); return b; }
__device__ __forceinline__ int LG() { int g = (int)gridDim.x; asm volatile("" : "+s"(g)); return g; }
#define AS4 __attribute__((address_space(4)))
struct ArgView { const AS4 unsigned char* kp;
    __device__ __forceinline__ const float* in(int i) const { return *(const float* const AS4*)(kp + 8 * i); }
    __device__ __forceinline__ float* out() const { return *(float* const AS4*)(kp + 192); }
    __device__ __forceinline__ unsigned char* ws() const { return *(unsigned char* const AS4*)(kp + 200); }
};
__device__ __forceinline__ ArgView argview() { const AS4 unsigned char* kp = (const AS4 unsigned char*)__builtin_amdgcn_kernarg_segment_ptr(); asm volatile("" : "+s"(kp)); return ArgView{kp}; }

__device__ __forceinline__ void p0_transpose_item(const float* W, int K, int N, bf16_t* WT, const float* gk, int glu_perm, LAS float* scr, int item, int lane) {
    const int nblk = N / 32, kb = item / nblk, nb = item % nblk, k0 = 64 * kb, n0 = 32 * nb;
    float wv[32];
#pragma unroll
    for (int i = 0; i < 32; ++i) wv[i] = W[(size_t)(k0 + 2 * i + (lane >> 5)) * N + n0 + (lane & 31)];
    if (gk) {
#pragma unroll
        for (int i = 0; i < 32; ++i) wv[i] *= gk[k0 + 2 * i + (lane >> 5)]; }
#pragma unroll
    for (int i = 0; i < 32; ++i) scr[(2 * i + (lane >> 5)) * 33 + (lane & 31)] = wv[i];
    LDS_WAIT();
    const int c = lane & 7;
#pragma unroll
    for (int j = 0; j < 4; ++j) { const int n = (lane >> 3) + 8 * j; const LAS float* s = scr + (8 * c) * 33 + n;
        u32x4 o; o.x = pk2(s[0 * 33], s[1 * 33]); o.y = pk2(s[2 * 33], s[3 * 33]); o.z = pk2(s[4 * 33], s[5 * 33]); o.w = pk2(s[6 * 33], s[7 * 33]);
        int nrow = n0 + n;
        if (glu_perm) nrow = (nrow < 1024) ? ((nrow >> 7) * 256 + (nrow & 127)) : ((((nrow - 1024) >> 7) * 256) + 128 + ((nrow - 1024) & 127));
        *(u32x4*)(WT + (size_t)nrow * K + k0 + 8 * c) = o; }
    LDS_WAIT();
}
__device__ __forceinline__ void prologue(const ArgView a, LAS unsigned char* lds, int wave, int lane) {
    lane = (int)__builtin_amdgcn_mbcnt_hi(~0u, __builtin_amdgcn_mbcnt_lo(~0u, 0u)); asm volatile("" : "+v"(lane));
    LAS float* scr = (LAS float*)(lds + wave * 16384);
    unsigned char* ws = a.ws();
    const int gw = blockIdx.x * NWAVES + wave, NGW = gridDim.x * NWAVES;
    constexpr int I_IN = 16 * 80, I_SQ = 16 * 32, I_UP = 16 * 128, I_DN = 64 * 32, I_P1 = 16 * 64, I_G = 16;
    constexpr int NITEMS = I_IN + I_SQ + I_UP + I_DN + I_P1 + I_SQ + I_UP + I_DN + I_G + I_G;
    for (int it = gw; it < NITEMS; it += NGW) {
        int r = it;
        if (r < I_IN) { p0_transpose_item(a.in(2), 1024, NPROJ, (bf16_t*)(ws + WS_WIN), a.in(1), 0, scr, r, lane); continue; } r -= I_IN;
        if (r < I_SQ) { p0_transpose_item(a.in(10), 1024, 1024, (bf16_t*)(ws + WS_WOUT), nullptr, 0, scr, r, lane); continue; } r -= I_SQ;
        if (r < I_UP) { p0_transpose_item(a.in(21), 1024, FF, (bf16_t*)(ws + WS_W1A), a.in(20), 0, scr, r, lane); continue; } r -= I_UP;
        if (r < I_DN) { p0_transpose_item(a.in(22), FF, 1024, (bf16_t*)(ws + WS_W2A), nullptr, 0, scr, r, lane); continue; } r -= I_DN;
        if (r < I_P1) { p0_transpose_item(a.in(12), 1024, 2048, (bf16_t*)(ws + WS_PW1), a.in(11), 1, scr, r, lane); continue; } r -= I_P1;
        if (r < I_SQ) { p0_transpose_item(a.in(18), 1024, 1024, (bf16_t*)(ws + WS_PW2), nullptr, 0, scr, r, lane); continue; } r -= I_SQ;
        if (r < I_UP) { p0_transpose_item(a.in(21) + (size_t)1024 * FF, 1024, FF, (bf16_t*)(ws + WS_W1B), a.in(20) + 1024, 0, scr, r, lane); continue; } r -= I_UP;
        if (r < I_DN) { p0_transpose_item(a.in(22) + (size_t)1024 * FF, FF, 1024, (bf16_t*)(ws + WS_W2B), nullptr, 0, scr, r, lane); continue; } r -= I_DN;
        if (r < I_G) { const int h = r >> 1; p0_transpose_item(a.in(5) + h * 4096, 64, 64, (bf16_t*)(ws + WS_GA) + h * 4096, nullptr, 0, scr, r & 1, lane); continue; } r -= I_G;
        { const int h = r >> 1; p0_transpose_item(a.in(7) + h * 4096, 64, 64, (bf16_t*)(ws + WS_GX) + h * 4096, nullptr, 0, scr, r & 1, lane); }
    }
    const float* x = a.in(0); bf16_t* XB = (bf16_t*)(ws + WS_XB); float* SS = (float*)(ws + WS_SS);
    for (int m0 = 4 * gw; m0 < M; m0 += 4 * NGW) {
        f32x4 v[4][4];
#pragma unroll
        for (int r = 0; r < 4; ++r)
#pragma unroll
            for (int j = 0; j < 4; ++j) v[r][j] = ((const f32x4*)(x + (size_t)(m0 + r) * D) + lane)[64 * j];
#pragma unroll
        for (int r = 0; r < 4; ++r) { u32x2* o8 = (u32x2*)(XB + (size_t)(m0 + r) * D) + lane; float s = 0.f;
#pragma unroll
            for (int j = 0; j < 4; ++j) { const f32x4 q = v[r][j]; s += (q.x * q.x + q.y * q.y) + (q.z * q.z + q.w * q.w); u32x2 w; w.x = pk2(q.x, q.y); w.y = pk2(q.z, q.w); o8[64 * j] = w; }
            s = wave_sum(s); if (lane == 0) SS[m0 + r] = s; }
    }
    for (int i = blockIdx.x * 512 + wave * 64 + lane; i < 4 * M; i += gridDim.x * 512) SS[M + i] = 0.f;
}

template <int PASS> __device__ __forceinline__ void lru_item(const ArgView a, LAS unsigned char* wlds, int item, int lane) {
    lane = (int)__builtin_amdgcn_mbcnt_hi(~0u, __builtin_amdgcn_mbcnt_lo(~0u, 0u)); asm volatile("" : "+v"(lane));
    unsigned char* ws = a.ws();
    const bf16_t* PROJ = (const bf16_t*)(ws + WS_PROJ); bf16_t* YMIX = (bf16_t*)(ws + WS_YMIX); float* SUM = (float*)(ws + WS_SUM);
    const int b = item >> 8, c128 = (item >> 3) & 31, h = item & 7;
    const int n = lane & 31, hi = lane >> 5, r8 = lane >> 3, cgp = lane & 7;
    LAS float* XC = (LAS float*)wlds;
    const bf16_t* GA = (const bf16_t*)(ws + WS_GA) + h * 4096; const bf16_t* GX = (const bf16_t*)(ws + WS_GX) + h * 4096;
    bf16x8 wa[2][4], wx[2][4];
#pragma unroll
    for (int nb = 0; nb < 2; ++nb)
#pragma unroll
        for (int ks = 0; ks < 4; ++ks) { wa[nb][ks] = *(const bf16x8*)(GA + (32 * nb + n) * 64 + 16 * ks + 8 * hi); wx[nb][ks] = *(const bf16x8*)(GX + (32 * nb + n) * 64 + 16 * ks + 8 * hi); }
    float ba[2], bx[2], ls8[2], Hc[2], Pt[2];
#pragma unroll
    for (int nb = 0; nb < 2; ++nb) { const int ch = 64 * h + 32 * nb + n; ba[nb] = -LOG2E * a.in(6)[ch]; bx[nb] = -LOG2E * a.in(8)[ch];
        const float lam = a.in(9)[ch]; ls8[nb] = -8.0f * LOG2E * (fmaxf(-lam, 0.f) + log1pf(expf(-fabsf(lam))));
        Hc[nb] = 0.f; Pt[nb] = 1.f; }
    if (PASS == 2) {
        for (int cc0 = 0; cc0 < c128; cc0 += 8) {
            f32x2 ab[8][2];
#pragma unroll
            for (int u = 0; u < 8; ++u)
#pragma unroll
                for (int nb = 0; nb < 2; ++nb) ab[u][nb] = (cc0 + u < c128) ? *(const f32x2*)(SUM + ((size_t)((b * 32 + cc0 + u) * 512 + 64 * h + 32 * nb + n)) * 2) : (f32x2){1.f, 0.f};
#pragma unroll
            for (int u = 0; u < 8; ++u)
#pragma unroll
                for (int nb = 0; nb < 2; ++nb) Hc[nb] = ab[u][nb].x * Hc[nb] + ab[u][nb].y; }
    }
    const bf16_t* Xr = PROJ + (size_t)b * SEQ * NPROJ + 512 + 64 * h + 8 * cgp;
    u32x4 xin[7];
#pragma unroll
    for (int i = 0; i < 7; ++i) { const int t = 128 * c128 + 4 * r8 - 3 + i; xin[i] = (t >= 0) ? *(const u32x4*)(Xr + (size_t)t * NPROJ) : (u32x4){0u, 0u, 0u, 0u}; }
#pragma unroll 1
    for (int sub = 0; sub < 4; ++sub) {
        const int t0 = 128 * c128 + 32 * sub;
        float cwv[4][8], cbv[8];
#pragma unroll
        for (int k = 0; k < 4; ++k) { const f32x4 w0 = *(const f32x4*)(a.in(3) + k * 512 + 64 * h + 8 * cgp), w1 = *(const f32x4*)(a.in(3) + k * 512 + 64 * h + 8 * cgp + 4);
#pragma unroll
            for (int e = 0; e < 4; ++e) { cwv[k][e] = w0[e]; cwv[k][4 + e] = w1[e]; } }
        { const f32x4 w0 = *(const f32x4*)(a.in(4) + 64 * h + 8 * cgp), w1 = *(const f32x4*)(a.in(4) + 64 * h + 8 * cgp + 4);
#pragma unroll
          for (int e = 0; e < 4; ++e) { cbv[e] = w0[e]; cbv[4 + e] = w1[e]; } }
#pragma unroll
        for (int j = 0; j < 4; ++j) { float o[8];
#pragma unroll
            for (int e = 0; e < 8; ++e) o[e] = cbv[e];
#pragma unroll
            for (int k = 0; k < 4; ++k) { const u32x4 xv = xin[j + k];
#pragma unroll
                for (int e2 = 0; e2 < 4; ++e2) { o[2 * e2] += cwv[k][2 * e2] * bf_lo(xv[e2]); o[2 * e2 + 1] += cwv[k][2 * e2 + 1] * bf_hi(xv[e2]); } }
            *(LAS f32x4*)(XC + (4 * r8 + j) * 68 + 8 * cgp) = (f32x4){o[0], o[1], o[2], o[3]};
            *(LAS f32x4*)(XC + (4 * r8 + j) * 68 + 8 * cgp + 4) = (f32x4){o[4], o[5], o[6], o[7]}; }
        if (sub < 3) {
#pragma unroll
            for (int i = 0; i < 7; ++i) xin[i] = *(const u32x4*)(Xr + (size_t)(t0 + 32 + 4 * r8 - 3 + i) * NPROJ); }
        unsigned short gtv[2][16];
        if (PASS == 2) {
#pragma unroll
            for (int nb = 0; nb < 2; ++nb)
#pragma unroll
                for (int i = 0; i < 16; ++i) gtv[nb][i] = PROJ[((size_t)b * SEQ + t0 + crow(i, hi)) * NPROJ + 64 * h + 32 * nb + n]; }
        LDS_WAIT();
        bf16x8 af[4];
#pragma unroll
        for (int ks = 0; ks < 4; ++ks) { const f32x4 lo = *(const LAS f32x4*)(XC + n * 68 + 16 * ks + 8 * hi), hv = *(const LAS f32x4*)(XC + n * 68 + 16 * ks + 8 * hi + 4);
            u32x4 w; w.x = pk2(lo[0], lo[1]); w.y = pk2(lo[2], lo[3]); w.z = pk2(hv[0], hv[1]); w.w = pk2(hv[2], hv[3]); af[ks] = __builtin_bit_cast(bf16x8, w); }
#pragma unroll
        for (int nb = 0; nb < 2; ++nb) {
            f32x16 accA = {}, accX = {};
#pragma unroll
            for (int ks = 0; ks < 4; ++ks) { accA = __builtin_amdgcn_mfma_f32_32x32x16_bf16(af[ks], wa[nb][ks], accA, 0, 0, 0); accX = __builtin_amdgcn_mfma_f32_32x32x16_bf16(af[ks], wx[nb][ks], accX, 0, 0, 0); }
            float av[16], iv[16];
#pragma unroll
            for (int i = 0; i < 16; ++i) { const float xv = XC[crow(i, hi) * 68 + 32 * nb + n];
                const float r = __builtin_amdgcn_rcpf(1.f + fexp2(accA[i] * (-LOG2E) + ba[nb])), ig = __builtin_amdgcn_rcpf(1.f + fexp2(accX[i] * (-LOG2E) + bx[nb]));
                const float la2 = ls8[nb] * r, aa = fexp2(la2), y = la2 * (2.0f * LN2);
                const float pl = -y * (1.f + y * (0.5f + y * (0.16666667f + y * (0.041666668f + y * 0.0083333338f))));
                const float m2 = (y > -0.25f) ? pl : (1.f - aa * aa);
                av[i] = aa; iv[i] = __builtin_amdgcn_sqrtf(fmaxf(m2, 0.f)) * (ig * xv); }
            float Ag[4], Bg[4], oA[4], oB[4];
#pragma unroll
            for (int g = 0; g < 4; ++g) { float A = av[4 * g], B = iv[4 * g];
#pragma unroll
                for (int j = 1; j < 4; ++j) { B = av[4 * g + j] * B + iv[4 * g + j]; A *= av[4 * g + j]; }
                Ag[g] = A; Bg[g] = B; }
#pragma unroll
            for (int g = 0; g < 4; ++g) { oA[g] = __shfl_xor(Ag[g], 32); oB[g] = __shfl_xor(Bg[g], 32); }
            float S = Hc[nb], st[4], P = Pt[nb];
#pragma unroll
            for (int g = 0; g < 4; ++g) { const float A0 = hi ? oA[g] : Ag[g], B0 = hi ? oB[g] : Bg[g], A1 = hi ? Ag[g] : oA[g], B1 = hi ? Bg[g] : oB[g];
                const float S1 = A0 * S + B0; st[g] = hi ? S1 : S; S = A1 * S1 + B1; P *= A0 * A1; }
            Hc[nb] = S; Pt[nb] = P;
            if (PASS == 2) {
                const size_t mrow = (size_t)b * SEQ + t0; const int ch = 64 * h + 32 * nb + n;
#pragma unroll
                for (int g = 0; g < 4; ++g) { float hh = st[g];
#pragma unroll
                    for (int j = 0; j < 4; ++j) { const int i = 4 * g + j; hh = av[i] * hh + iv[i];
                        const size_t mr = mrow + crow(i, hi); const float gt = bf1(gtv[nb][i]);
                        const float u2 = 1.5957691216057308f * (gt + 0.044715f * gt * gt * gt);
                        const float th = 1.f - 2.f * __builtin_amdgcn_rcpf(1.f + fexp(u2));
                        const float y = 0.5f * gt * (1.f + th) * hh;
                        YMIX[mr * 1024 + ch] = (bf16_t)(pk2(y, y) & 0xffffu); } }
            }
        }
        LDS_WAIT();
    }
    if (PASS == 1 && hi == 0) {
#pragma unroll
        for (int nb = 0; nb < 2; ++nb) *(f32x2*)(SUM + ((size_t)((b * 32 + c128) * 512 + 64 * h + 32 * nb + n)) * 2) = (f32x2){Pt[nb], Hc[nb]};
    }
}

__device__ __forceinline__ void attn_item(const ArgView a, LAS unsigned char* wlds, int item, int lane) {
    lane = (int)__builtin_amdgcn_mbcnt_hi(~0u, __builtin_amdgcn_mbcnt_lo(~0u, 0u)); asm volatile("" : "+v"(lane));
    unsigned char* ws = a.ws();
    const int b = item >> 10, h = (item >> 7) & 7, qi = item & 127;
    const int n = lane & 31, hi = lane >> 5;
    const bf16_t* Pb = (const bf16_t*)(ws + WS_PROJ) + (size_t)b * SEQ * NPROJ;
    bf16_t* YMIX = (bf16_t*)(ws + WS_YMIX);
    const bf16_t* Kl = Pb + (size_t)n * NPROJ + 1536 + 64 * h + 8 * hi;
    const bf16_t* Vl = Pb + (size_t)(lane >> 3) * NPROJ + 2048 + 64 * h + 8 * (lane & 7);
    const int vst = (lane >> 3) * 144 + (lane & 7) * 16;
    bf16x8 qf[4], kfN[4]; u32x4 vN[4];
#pragma unroll
    for (int ks = 0; ks < 4; ++ks) qf[ks] = *(const bf16x8*)(Pb + (size_t)(32 * qi + n) * NPROJ + 1024 + 64 * h + 16 * ks + 8 * hi);
#pragma unroll
    for (int ks = 0; ks < 4; ++ks) kfN[ks] = *(const bf16x8*)(Kl + (size_t)(32 * qi) * NPROJ + 16 * ks);
#pragma unroll
    for (int j = 0; j < 4; ++j) vN[j] = *(const u32x4*)(Vl + (size_t)(32 * qi + 8 * j) * NPROJ);
    f32x16 o0 = {}, o1 = {}; float carry = 1.f; int cur = 0;
    for (int kt = qi; kt >= 0; --kt) {
        bf16x8 kf[4];
#pragma unroll
        for (int ks = 0; ks < 4; ++ks) kf[ks] = kfN[ks];
        LAS unsigned char* vb = wlds + cur * 4608;
#pragma unroll
        for (int j = 0; j < 4; ++j) *(LAS u32x4*)(vb + vst + j * 8 * 144) = vN[j];
        asm volatile("" ::: "memory");
        if (kt > 0) {
#pragma unroll
            for (int ks = 0; ks < 4; ++ks) kfN[ks] = *(const bf16x8*)(Kl + (size_t)(32 * (kt - 1)) * NPROJ + 16 * ks);
#pragma unroll
            for (int j = 0; j < 4; ++j) vN[j] = *(const u32x4*)(Vl + (size_t)(32 * (kt - 1) + 8 * j) * NPROJ);
        }
        f32x16 s = {};
#pragma unroll
        for (int ks = 0; ks < 4; ++ks) s = __builtin_amdgcn_mfma_f32_32x32x16_bf16(kf[ks], qf[ks], s, 0, 0, 0);
        float kp[16], bt[16];
#pragma unroll
        for (int i = 0; i < 16; ++i) { const float e = fexp2(fminf(s[i] * (0.125f * LOG2E), 100.f)); kp[i] = __builtin_amdgcn_rcpf(1.f + e); bt[i] = e * kp[i]; }
        if (kt == qi) {
#pragma unroll
            for (int i = 0; i < 16; ++i) { const bool valid = crow(i, hi) < n; kp[i] = valid ? kp[i] : 1.f; bt[i] = valid ? bt[i] : 0.f; }
        }
        float T[4], oT[4], after[4];
#pragma unroll
        for (int g = 0; g < 4; ++g) T[g] = (kp[4 * g] * kp[4 * g + 1]) * (kp[4 * g + 2] * kp[4 * g + 3]);
#pragma unroll
        for (int g = 0; g < 4; ++g) oT[g] = __shfl_xor(T[g], 32);
        float Gs = 1.f;
#pragma unroll
        for (int g = 3; g >= 0; --g) { after[g] = hi ? Gs : Gs * oT[g]; Gs *= T[g] * oT[g]; }
        float w[16];
#pragma unroll
        for (int g = 0; g < 4; ++g) { float suf = carry * after[g];
#pragma unroll
            for (int j = 3; j >= 0; --j) { const int i = 4 * g + j; w[i] = bt[i] * suf; suf *= kp[i]; } }
        carry *= Gs;
        bf16x8 pf[2];
#pragma unroll
        for (int s2 = 0; s2 < 2; ++s2) { u32x4 pw; pw.x = pk2(w[8 * s2], w[8 * s2 + 1]); pw.y = pk2(w[8 * s2 + 2], w[8 * s2 + 3]); pw.z = pk2(w[8 * s2 + 4], w[8 * s2 + 5]); pw.w = pk2(w[8 * s2 + 6], w[8 * s2 + 7]);
            pf[s2] = __builtin_bit_cast(bf16x8, pw); }
#pragma unroll
        for (int d0 = 0; d0 < 2; ++d0)
#pragma unroll
            for (int s2 = 0; s2 < 2; ++s2) { bf16x8 vf;
#pragma unroll
                for (int e = 0; e < 2; ++e)
#pragma unroll
                    for (int j = 0; j < 4; ++j) vf[4 * e + j] = *(const LAS short*)(vb + (16 * s2 + 4 * hi + j + 8 * e) * 144 + (32 * d0 + n) * 2);
                if (d0 == 0) o0 = __builtin_amdgcn_mfma_f32_32x32x16_bf16(vf, pf[s2], o0, 0, 0, 0); else o1 = __builtin_amdgcn_mfma_f32_32x32x16_bf16(vf, pf[s2], o1, 0, 0, 0); }
        asm volatile("" ::: "memory");
        cur ^= 1;
        if (__all(carry < 1e-30f)) break;
    }
    LDS_WAIT();
    bf16_t* orow = YMIX + ((size_t)b * SEQ + 32 * qi + n) * 1024 + 512 + 64 * h;
#pragma unroll
    for (int g = 0; g < 4; ++g) { u32x2 w0, w1; w0.x = pk2(o0[4 * g], o0[4 * g + 1]); w0.y = pk2(o0[4 * g + 2], o0[4 * g + 3]); w1.x = pk2(o1[4 * g], o1[4 * g + 1]); w1.y = pk2(o1[4 * g + 2], o1[4 * g + 3]);
        *(u32x2*)(orow + 8 * g + 4 * hi) = w0; *(u32x2*)(orow + 32 + 8 * g + 4 * hi) = w1; }
}

__device__ __forceinline__ void conv_phase(const ArgView a, LAS unsigned char* lds, int wave, int lane) {
    lane = (int)__builtin_amdgcn_mbcnt_hi(~0u, __builtin_amdgcn_mbcnt_lo(~0u, 0u)); asm volatile("" : "+v"(lane));
    unsigned char* ws = a.ws();
    const bf16_t* GL = (const bf16_t*)(ws + WS_GL); bf16_t* CV = (bf16_t*)(ws + WS_CV);
    const int c = 128 * wave + 2 * lane;
    f32x2 wk[31];
#pragma unroll
    for (int k = 0; k < 31; ++k) wk[k] = *(const f32x2*)(a.in(14) + k * 1024 + c);
    const f32x2 bb = *(const f32x2*)(a.in(15) + c);
    LAS float* CT = (LAS float*)lds;
    for (int tile = LB(); tile < M / 32; tile += gridDim.x) {
        const int b = tile >> 7, t0 = (tile & 127) * 32; const bf16_t* G = GL + (size_t)b * SEQ * 1024 + c;
        unsigned X[38];
#pragma unroll
        for (int i = 0; i < 30; ++i) { const int t = t0 - 30 + i; X[i] = (t >= 0) ? *(const unsigned*)(G + (size_t)t * 1024) : 0u; }
#pragma unroll
        for (int j = 0; j < 8; ++j) X[30 + j] = *(const unsigned*)(G + (size_t)(t0 + j) * 1024);
#pragma unroll 1
        for (int ch = 0; ch < 4; ++ch) {
            unsigned NX[8];
            if (ch < 3) {
#pragma unroll
                for (int j = 0; j < 8; ++j) NX[j] = *(const unsigned*)(G + (size_t)(t0 + 8 * ch + 8 + j) * 1024); }
            else {
#pragma unroll
                for (int j = 0; j < 8; ++j) NX[j] = 0u; }
            f32x2 acc[8];
#pragma unroll
            for (int j = 0; j < 8; ++j) acc[j] = bb;
#pragma unroll
            for (int i = 0; i < 38; ++i) { const f32x2 xv = (f32x2){bf_lo(X[i]), bf_hi(X[i])};
#pragma unroll
                for (int j = 0; j < 8; ++j) { const int k = i - j; if (k >= 0 && k <= 30) acc[j] += wk[k] * xv; } }
#pragma unroll
            for (int j = 0; j < 8; ++j) *(LAS f32x2*)(CT + (8 * ch + j) * 1024 + c) = acc[j];
#pragma unroll
            for (int i = 0; i < 30; ++i) X[i] = X[i + 8];
#pragma unroll
            for (int j = 0; j < 8; ++j) X[30 + j] = NX[j];
        }
        __syncthreads();
#pragma unroll 1
        for (int tt = 0; tt < 4; ++tt) { const int tok = 4 * wave + tt; const size_t m = (size_t)b * SEQ + t0 + tok;
            f32x4 v[4]; float s = 0.f;
#pragma unroll
            for (int j = 0; j < 4; ++j) { v[j] = *(const LAS f32x4*)(CT + tok * 1024 + 4 * lane + 256 * j); s += (v[j].x + v[j].y) + (v[j].z + v[j].w); }
            const float mean = wave_sum(s) * (1.0f / 1024.0f); float s2 = 0.f;
#pragma unroll
            for (int j = 0; j < 4; ++j) { v[j] = v[j] - mean; s2 += (v[j].x * v[j].x + v[j].y * v[j].y) + (v[j].z * v[j].z + v[j].w * v[j].w); }
            const float rstd = rsqrtf(wave_sum(s2) * (1.0f / 1024.0f) + LN_EPS);
#pragma unroll
            for (int j = 0; j < 4; ++j) { const f32x4 g = *(const f32x4*)(a.in(16) + 4 * lane + 256 * j), bt = *(const f32x4*)(a.in(17) + 4 * lane + 256 * j);
                f32x4 y = v[j] * rstd * g + bt;
#pragma unroll
                for (int e = 0; e < 4; ++e) y[e] = y[e] * fsigmoid(y[e]);
                u32x2 w; w.x = pk2(y[0], y[1]); w.y = pk2(y[2], y[3]); *(u32x2*)(CV + m * 1024 + 4 * lane + 256 * j) = w; }
        }
        __syncthreads();
    }
}

#define XB_TMO      128
#define XB_XCNT(j)  (256  + 64 * (j))
#define XB_XSUB(j)  (1280 + 64 * (j))
#define XB_XGEN(j)  (2304 + 64 * (j))
#define XB_TOP      3328
#define XB_TOPGEN   3392
#define XCD_BAR_WORDS 3456
#define XB_SPIN_CAP (1u << 18)

__device__ __forceinline__ unsigned xb_ld(unsigned* p)              { return __hip_atomic_load(p, __ATOMIC_RELAXED, __HIP_MEMORY_SCOPE_AGENT); }
__device__ __forceinline__ unsigned xb_add(unsigned* p, unsigned v) { return __hip_atomic_fetch_add(p, v, __ATOMIC_RELAXED, __HIP_MEMORY_SCOPE_AGENT); }
__device__ __forceinline__ unsigned xb_xcc_id() { return (unsigned)__builtin_amdgcn_s_getreg((3 << 11) | 20) & 0xFu; }
#define XB_SPIN(cond, bar) do { unsigned _sp = 0; while (cond) { __builtin_amdgcn_s_sleep(1); \
    if ((++_sp & 255u) == 0u) { if (xb_ld(&(bar)[XB_TMO])) break; if (_sp > XB_SPIN_CAP) { atomicAdd(&(bar)[XB_TMO], 1u); break; } } } } while (0)

struct XcdBarrier {
    unsigned* bar; unsigned x;
    volatile LAS unsigned* st;
};

__device__ __forceinline__ XcdBarrier xcd_barrier_post(unsigned* bar, volatile LAS unsigned* st) {
    XcdBarrier b; b.bar = bar; b.x = xb_xcc_id(); b.st = st;
    if (threadIdx.x == 0) (void)xb_add(&bar[XB_XCNT(b.x)], 1u);
    return b;
}
__device__ __forceinline__ void xcd_barrier_complete(unsigned* bar, unsigned x, unsigned& nloc, unsigned& nx) {
    const unsigned G = gridDim.x * gridDim.y * gridDim.z;
    unsigned sum, cnt, mine, sp = 0u;
    for (;;) {
        sum = 0u; cnt = 0u; mine = 0u;
#pragma unroll
        for (unsigned j = 0; j < 16; ++j) { const unsigned c = xb_ld(&bar[XB_XCNT(j)]); sum += c; cnt += (c > 0u) ? 1u : 0u; mine = (j == x) ? c : mine; }
        if (sum == G) break;
        __builtin_amdgcn_s_sleep(1);
        if ((++sp & 255u) == 0u) { if (xb_ld(&bar[XB_TMO])) break; if (sp > XB_SPIN_CAP) { atomicAdd(&bar[XB_TMO], 1u); break; } }
    }
    nloc = mine > 0u ? mine : 1u; nx = cnt > 0u ? cnt : 1u;
}

__device__ __forceinline__ void xcd_barrier(const XcdBarrier& b) {
    asm volatile("s_waitcnt vmcnt(0)" ::: "memory");
    __syncthreads();
    if (threadIdx.x == 0) {
        unsigned* bar = b.bar; asm volatile("" : "+s"(bar)); unsigned bx = b.x; asm volatile("" : "+s"(bx));
        __builtin_amdgcn_s_waitcnt(0);
        unsigned nloc = b.st[0], nx = b.st[1];
        if (nloc == 0u) { xcd_barrier_complete(bar, bx, nloc, nx); b.st[0] = nloc; b.st[1] = nx; }
        const unsigned old = xb_add(&bar[XB_XSUB(bx)], 1u);
        const unsigned gen = old / nloc;
        if (old + 1u == (gen + 1u) * nloc) {
            __builtin_amdgcn_fence(__ATOMIC_RELEASE, "agent");
            asm volatile("s_waitcnt vmcnt(0)" ::: "memory");
            const unsigned og = xb_add(&bar[XB_TOP], 1u);
            const unsigned tg = og / nx;
            if (og + 1u == (tg + 1u) * nx) xb_add(&bar[XB_TOPGEN], 1u);
            else XB_SPIN(xb_ld(&bar[XB_TOPGEN]) == tg, bar);
            __builtin_amdgcn_fence(__ATOMIC_ACQUIRE, "agent");
            xb_add(&bar[XB_XGEN(bx)], 1u);
            asm volatile("s_waitcnt vmcnt(0)" ::: "memory");
        } else {
            XB_SPIN(xb_ld(&bar[XB_XGEN(bx)]) == gen, bar);
            __builtin_amdgcn_fence(__ATOMIC_ACQUIRE, "agent");
            asm volatile("s_waitcnt vmcnt(0)" ::: "memory");
        }
    }
    __syncthreads();
}

__global__ void __launch_bounds__(NWAVES * 64, 2) trunk_fwd(Args kargs) {
    extern __shared__ __attribute__((aligned(16))) unsigned char lds_raw[];
    cg::grid_group grid = cg::this_grid();
    LAS unsigned char* lds = (LAS unsigned char*)lds_raw;
    const int wave = __builtin_amdgcn_readfirstlane((int)threadIdx.x >> 6); int lane = 0;
    const int G = gridDim.x, gw = blockIdx.x * NWAVES + wave, NGW = G * NWAVES;
    LAS unsigned char* wlds = lds + wave * 16384;
    volatile LAS unsigned* MISC = (volatile LAS unsigned*)(lds + MISC_OFF);
    if (threadIdx.x < 32) MISC[threadIdx.x] = 0u;
    __syncthreads();
    XcdBarrier bar = xcd_barrier_post((unsigned*)(argview().ws() + WS_BAR), MISC + 8);
#define GRID_BAR() xcd_barrier(bar)

    for (int rep = 0; rep < PROBE_P; ++rep) prologue(argview(), lds, wave, lane);
    if (gridDim.y != 1) grid.sync();
    GRID_BAR();
#pragma unroll 1
    for (int L = 0; L < 2; ++L) {
        if (L == 0) {
            { const ArgView a = argview(); unsigned char* ws = a.ws();
              pg8::Gemm g{(const bf16_t*)(ws + WS_XB), (const bf16_t*)(ws + WS_WIN), M, NPROJ, D}; pg8::StaticOrder S; S.init(M, NPROJ, LG(), LB());
              pg8::EpiScale<0> E{(bf16_t*)(ws + WS_PROJ), NPROJ, (const float*)(ws + WS_SS)};
              pg8::gemm_phase<pg8::EpiScale<0>, pg8::StaticOrder, true, true>(lds, g, S, E, wave); }
            GRID_BAR();
            for (int rep = 0; rep < PROBE_X; ++rep) { const int gwl = LB() * NWAVES + wave, ngw = LG() * NWAVES;
              for (int it = gwl; it < 2048; it += ngw) lru_item<1>(argview(), wlds, it, lane);
              for (int it = gwl; it < 4096; it += ngw) attn_item(argview(), wlds, it, lane); }
            GRID_BAR();
            for (int rep = 0; rep < PROBE_X; ++rep) { const int gwl = LB() * NWAVES + wave, ngw = LG() * NWAVES;
              for (int it = gwl; it < 2048; it += ngw) lru_item<2>(argview(), wlds, it, lane);
              for (int it = 4096 + gwl; it < 8192; it += ngw) attn_item(argview(), wlds, it, lane); }
            GRID_BAR();
        } else {
            { const ArgView a = argview(); unsigned char* ws = a.ws();
              pg8::Gemm g{(const bf16_t*)(ws + WS_XB), (const bf16_t*)(ws + WS_PW1), M, 2048, D}; pg8::StaticOrder S; S.init(M, 2048, LG(), LB());
              pg8::EpiGlu E{(bf16_t*)(ws + WS_GL), (const float*)(ws + WS_SS) + 2 * M, a.in(13)};
              pg8::gemm_phase<pg8::EpiGlu, pg8::StaticOrder, true, true>(lds, g, S, E, wave); }
            GRID_BAR();
            for (int rep = 0; rep < PROBE_C; ++rep) conv_phase(argview(), lds, wave, lane);
            GRID_BAR();
        }
        { const ArgView a = argview(); unsigned char* ws = a.ws();
          pg8::Gemm g{(const bf16_t*)(ws + (L == 0 ? WS_YMIX : WS_CV)), (const bf16_t*)(ws + (L == 0 ? WS_WOUT : WS_PW2)), M, D, D}; pg8::StaticOrder S; S.init(M, D, LG(), LB());
          pg8::EpiResid E{L == 0 ? a.in(0) : nullptr, (const bf16_t*)(ws + WS_XB), nullptr, (bf16_t*)(ws + WS_XB), L == 0 ? nullptr : a.in(19), (float*)(ws + WS_SS) + (2 * L + 1) * M};
          pg8::gemm_phase<pg8::EpiResid, pg8::StaticOrder, true, true>(lds, g, S, E, wave); }
        GRID_BAR();
        { const ArgView a = argview(); unsigned char* ws = a.ws();
          pg8::Gemm g{(const bf16_t*)(ws + WS_XB), (const bf16_t*)(ws + (L == 0 ? WS_W1A : WS_W1B)), M, FF, D}; pg8::StaticOrder S; S.init(M, FF, LG(), LB());
          pg8::EpiScale<1> E{(bf16_t*)(ws + WS_H), FF, (const float*)(ws + WS_SS) + (2 * L + 1) * M};
          pg8::gemm_phase<pg8::EpiScale<1>, pg8::StaticOrder, true, true>(lds, g, S, E, wave); }
        GRID_BAR();
        { const ArgView a = argview(); unsigned char* ws = a.ws();
          pg8::Gemm g{(const bf16_t*)(ws + WS_H), (const bf16_t*)(ws + (L == 0 ? WS_W2A : WS_W2B)), M, D, FF}; pg8::StaticOrder S; S.init(M, D, LG(), LB());
          pg8::EpiResid E{nullptr, (const bf16_t*)(ws + WS_XB), nullptr, (bf16_t*)(ws + WS_XB), nullptr, (float*)(ws + WS_SS) + (2 * L + 2) * M};
          pg8::gemm_phase<pg8::EpiResid, pg8::StaticOrder, true, true>(lds, g, S, E, wave); }
        GRID_BAR();
    }
    { const ArgView a = argview(); const float* SS = (const float*)(a.ws() + WS_SS); const bf16_t* XBf = (const bf16_t*)(a.ws() + WS_XB); float* out = a.out(); const float* fg = a.in(23);
      lane = (int)__builtin_amdgcn_mbcnt_hi(~0u, __builtin_amdgcn_mbcnt_lo(~0u, 0u));
      f32x4 gv[4];
#pragma unroll
      for (int j = 0; j < 4; ++j) gv[j] = ((const f32x4*)fg + lane)[64 * j];
      for (int m0 = 4 * gw; m0 < M; m0 += 4 * NGW) {
        u32x2 v[4][4]; float rs[4];
#pragma unroll
        for (int r = 0; r < 4; ++r) { rs[r] = rsqrtf(SS[4 * M + m0 + r] * (1.0f / 1024.0f) + RMS_EPS);
#pragma unroll
            for (int j = 0; j < 4; ++j) v[r][j] = ((const u32x2*)(XBf + (size_t)(m0 + r) * D) + lane)[64 * j]; }
#pragma unroll
        for (int r = 0; r < 4; ++r)
#pragma unroll
            for (int j = 0; j < 4; ++j) { const f32x4 q = (f32x4){bf_lo(v[r][j].x), bf_hi(v[r][j].x), bf_lo(v[r][j].y), bf_hi(v[r][j].y)};
                ((f32x4*)(out + (size_t)(m0 + r) * D) + lane)[64 * j] = q * rs[r] * gv[j]; }
      } }
}

extern "C" void kernel_launch(void* const* d_in, const int* in_sizes, int n_in, void* d_out, int out_size, void* d_ws, size_t ws_size, hipStream_t stream) {
    static int grid = 0;
    if (grid == 0) {
        if (n_in != 24 || in_sizes[0] != M * D || out_size != M * D || ws_size < WS_END) { fprintf(stderr, "kernel_launch: unexpected shapes (n_in %d, ws %zu)\n", n_in, ws_size); grid = -1; return; }
        int dev = 0, cus = 0, per_cu = 0;
        hipGetDevice(&dev); hipDeviceGetAttribute(&cus, hipDeviceAttributeMultiprocessorCount, dev);
        hipFuncSetAttribute((const void*)trunk_fwd, hipFuncAttributeMaxDynamicSharedMemorySize, LDS_BYTES);
        hipOccupancyMaxActiveBlocksPerMultiprocessor(&per_cu, (const void*)trunk_fwd, NWAVES * 64, LDS_BYTES);
        if (per_cu < 1) per_cu = 1;
        (void)hipGetLastError();
        grid = cus * per_cu;
    }
    if (grid < 0) return;
    if (hipMemsetAsync((char*)d_ws + WS_BAR, 0, 16384, stream) != hipSuccess) { fprintf(stderr, "memset failed\n"); return; }
    Args a{};
    for (int i = 0; i < 24; ++i) a.in[i] = (const float*)d_in[i];
    a.out = (float*)d_out; a.ws = (unsigned char*)d_ws;
    void* args[] = {&a};
    hipError_t e = hipLaunchCooperativeKernel((const void*)trunk_fwd, dim3(grid), dim3(NWAVES * 64), args, LDS_BYTES, stream);
    if (e != hipSuccess) fprintf(stderr, "cooperative launch failed: %s (grid %d)\n", hipGetErrorString(e), grid);
}
```
